# Optimizing an MI355X kernel written in HIP

```python
import jax, jax.numpy as jnp
from jax import lax
import numpy as np

D_MODEL = 1024
BATCH = 2
SEQ = 8192
DEPTH = 4

M_HEADS = 4
M_HEAD_DIM = 128
M_WIDTH = M_HEADS * M_HEAD_DIM
M_CONV = 5
M_CHUNK = 64
B_HEADS = 8
B_HEAD_DIM = 64
B_WIDTH = B_HEADS * B_HEAD_DIM
DILATED_PAIRS = ((128, 1), (512, 4), (2048, 16))
AB_IN = 2 * M_WIDTH + M_WIDTH + M_WIDTH + 4 * M_HEADS + 3 * B_WIDTH
AB_MIX = M_WIDTH + B_WIDTH
C_HEADS = 16
C_KV_HEADS = 4
C_HEAD_DIM = 64
C_RADIUS = 128
C_IN = (C_HEADS + 2 * C_KV_HEADS) * C_HEAD_DIM
C_MIX = C_HEADS * C_HEAD_DIM
D_FF = 2816
N_EVEN = (DEPTH + 1) // 2
N_ODD = DEPTH // 2
EPS = 1e-6

kernel_name = "hybrid_mlstm_dilated_swa_macaron_encoder"


def rmsnorm(x, g):
    xf = x.astype(jnp.float32)
    y = xf * lax.rsqrt(jnp.mean(xf * xf, axis=-1, keepdims=True) + EPS) * g.astype(jnp.float32)
    return y.astype(x.dtype)


def swiglu(h, w1, w3, w2):
    return (jax.nn.silu(h @ w1) * (h @ w3)) @ w2


def alibi_slopes(n):
    return jnp.exp2(-8.0 * jnp.arange(1, n + 1, dtype=jnp.float32) / n)


def banded_attention(q, k, v, radius, dist_unit, slopes, sink):
    N, L, K, G, E = q.shape
    Q = radius
    n = -(-L // Q)
    Lp = n * Q
    qb = jnp.pad(q, ((0, 0), (0, Lp - L), (0, 0), (0, 0), (0, 0))).reshape(N, n, Q, K, G, E)
    qb = jnp.moveaxis(qb, 1, 0)
    kp = jnp.pad(k, ((0, 0), (Q, Lp - L + Q), (0, 0), (0, 0)))
    vp = jnp.pad(v, ((0, 0), (Q, Lp - L + Q), (0, 0), (0, 0)))
    rel = jnp.arange(3 * Q)[None, :] - Q - jnp.arange(Q)[:, None]
    bias = -slopes[:, :, None, None] * (dist_unit * jnp.abs(rel)).astype(jnp.float32)
    in_window = jnp.abs(rel) <= radius
    scale = E ** -0.5

    def block(args):
        i, qi = args
        ki = lax.dynamic_slice_in_dim(kp, i * Q, 3 * Q, axis=1).astype(jnp.float32)
        vi = lax.dynamic_slice_in_dim(vp, i * Q, 3 * Q, axis=1).astype(jnp.float32)
        s = jnp.einsum('zqhge,zshe->zhgqs', qi.astype(jnp.float32), ki) * scale + bias
        kpos = i * Q - Q + jnp.arange(3 * Q)
        valid = in_window & ((kpos >= 0) & (kpos < L))[None, :]
        s = jnp.where(valid, s, -jnp.inf)
        m = s.max(-1)
        if sink is not None:
            m = jnp.maximum(m, sink[None, :, :, None])
        p = jnp.exp(s - m[..., None])
        den = p.sum(-1)
        if sink is not None:
            den = den + jnp.exp(sink[None, :, :, None] - m)
        o = jnp.einsum('zhgqs,zshe->zqhge', p, vi) / jnp.moveaxis(den, 3, 1)[..., None]
        lse = jnp.moveaxis(m + jnp.log(den), 3, 1)
        return o, lse

    o, lse = lax.map(block, (jnp.arange(n), qb))
    o = jnp.moveaxis(o, 0, 1).reshape(N, Lp, K, G, E)[:, :L]
    lse = jnp.moveaxis(lse, 0, 1).reshape(N, Lp, K, G)[:, :L]
    return o, lse


def to_residue(t, d):
    Bn, S = t.shape[:2]
    t = jnp.moveaxis(t.reshape((Bn, S // d, d) + t.shape[2:]), 2, 1)
    return t.reshape((Bn * d, S // d) + t.shape[3:])


def from_residue(t, Bn, d):
    L = t.shape[1]
    t = jnp.moveaxis(t.reshape((Bn, d, L) + t.shape[2:]), 1, 2)
    return t.reshape((Bn, L * d) + t.shape[3:])


def mlstm_chunkwise(q, k, v, i_pre, logf):
    Bn, H, S, E = q.shape
    L = M_CHUNK
    NC = S // L
    q, k, v = (t.reshape(Bn, H, NC, L, E) for t in (q, k, v))
    i_pre = i_pre.reshape(Bn, H, NC, L)
    b = jnp.cumsum(logf.reshape(Bn, H, NC, L), axis=-1)
    b_last = b[..., -1]
    a = b_last[..., None] - b + i_pre
    m_loc = a.max(-1)
    wa = jnp.exp(a - m_loc[..., None])
    C_chunk = jnp.einsum('bhcs,bhcsd,bhcse->bhcde', wa, v, k)
    n_chunk = jnp.einsum('bhcs,bhcse->bhce', wa, k)

    def step(carry, inp):
        C, n, m = carry
        Cc, nc, mc, bc = inp
        m_new = jnp.maximum(bc + m, mc)
        s_old = jnp.exp(bc + m - m_new)
        s_new = jnp.exp(mc - m_new)
        C_new = s_old[..., None, None] * C + s_new[..., None, None] * Cc
        n_new = s_old[..., None] * n + s_new[..., None] * nc
        return (C_new, n_new, m_new), (C, n, m)

    init = (jnp.zeros((Bn, H, E, E), q.dtype), jnp.zeros((Bn, H, E), q.dtype), jnp.zeros((Bn, H), q.dtype))
    cf = lambda t: jnp.moveaxis(t, 2, 0)
    _, (C_prev, n_prev, m_prev) = lax.scan(step, init, (cf(C_chunk), cf(n_chunk), cf(m_loc), cf(b_last)))
    C_prev, n_prev, m_prev = (jnp.moveaxis(t, 0, 2) for t in (C_prev, n_prev, m_prev))

    lower = jnp.tril(jnp.ones((L, L), dtype=bool))
    dmat = jnp.where(lower, b[..., :, None] - b[..., None, :] + i_pre[..., None, :], -jnp.inf)
    m_inter = b + m_prev[..., None]
    m_t = jnp.maximum(m_inter, dmat.max(-1))
    w = jnp.exp(dmat - m_t[..., None]) * jnp.einsum('bhcte,bhcse->bhcts', q, k)
    s_inter = jnp.exp(m_inter - m_t)
    num = jnp.einsum('bhcts,bhcsd->bhctd', w, v) + s_inter[..., None] * jnp.einsum('bhcde,bhcte->bhctd', C_prev, q)
    den = w.sum(-1) + s_inter * jnp.einsum('bhce,bhcte->bhct', n_prev, q)
    h = num / jnp.maximum(jnp.abs(den), jnp.exp(-m_t))[..., None]
    return h.reshape(Bn, H, S, E)


def mixer_ab(h, w_in, conv_w, conv_b, gate_b, hnorm_g, w_out):
    Bn, S, _ = h.shape
    f32 = jnp.float32
    proj = h @ w_in
    cuts = [2 * M_WIDTH, 3 * M_WIDTH, 4 * M_WIDTH, 4 * M_WIDTH + 4 * M_HEADS,
            4 * M_WIDTH + 4 * M_HEADS + B_WIDTH, 4 * M_WIDTH + 4 * M_HEADS + 2 * B_WIDTH]
    qk_m, v_m, o_m, g_m, q_b, k_b, v_b = jnp.split(proj, cuts, axis=-1)

    qk_m = lax.conv_general_dilated(qk_m, conv_w[:, None, :], (1,), 'SAME',
                                    dimension_numbers=('NWC', 'WIO', 'NWC'),
                                    feature_group_count=2 * M_WIDTH)
    qk_m = jax.nn.silu(qk_m + conv_b)
    q_m, k_m = jnp.split(qk_m, 2, axis=-1)
    heads = lambda t: t.reshape(Bn, S, M_HEADS, M_HEAD_DIM).transpose(0, 2, 1, 3).astype(f32)
    q_m, k_m, v_m = heads(q_m), heads(k_m) * (M_HEAD_DIM ** -0.5), heads(v_m)
    g = g_m.astype(f32).reshape(Bn, S, 2, 2, M_HEADS) + gate_b.astype(f32)
    g = g.transpose(2, 3, 0, 4, 1)
    i_pre, logf = g[0], jax.nn.log_sigmoid(g[1])
    fwd = mlstm_chunkwise(q_m, k_m, v_m, i_pre[0], logf[0])
    rev = lambda t: jnp.flip(t, axis=2)
    bwd = rev(mlstm_chunkwise(rev(q_m), rev(k_m), rev(v_m), rev(i_pre[1]), rev(logf[1])))
    hm = fwd + bwd
    hm = (hm * lax.rsqrt(jnp.mean(hm * hm, axis=-1, keepdims=True) + EPS)
          * hnorm_g.astype(f32).reshape(M_HEADS, 1, M_HEAD_DIM))
    hm = hm.transpose(0, 2, 1, 3).reshape(Bn, S, M_WIDTH) * jax.nn.sigmoid(o_m.astype(f32))

    qb = q_b.reshape(Bn, S, B_HEADS, 1, B_HEAD_DIM)
    kb = k_b.reshape(Bn, S, B_HEADS, B_HEAD_DIM)
    vb = v_b.reshape(Bn, S, B_HEADS, B_HEAD_DIM)
    slopes = alibi_slopes(B_HEADS).reshape(B_HEADS, 1)
    outs, lses = [], []
    for window, dil in DILATED_PAIRS:
        o, lse = banded_attention(to_residue(qb, dil), to_residue(kb, dil), to_residue(vb, dil),
                                  window // (2 * dil), dil, slopes, None)
        outs.append(from_residue(o, Bn, dil))
        lses.append(from_residue(lse, Bn, dil))
    wts = jax.nn.softmax(jnp.stack(lses), axis=0)
    ob = jnp.sum(wts[..., None] * jnp.stack(outs), axis=0).reshape(Bn, S, B_WIDTH)

    mixed = jnp.concatenate([hm, ob], axis=-1).astype(h.dtype)
    return mixed @ w_out


def mixer_c(h, w_in, sink, w_out):
    Bn, S, _ = h.shape
    G = C_HEADS // C_KV_HEADS
    proj = h @ w_in
    q, k, v = jnp.split(proj, [C_HEADS * C_HEAD_DIM, (C_HEADS + C_KV_HEADS) * C_HEAD_DIM], axis=-1)
    q = q.reshape(Bn, S, C_KV_HEADS, G, C_HEAD_DIM)
    k = k.reshape(Bn, S, C_KV_HEADS, C_HEAD_DIM)
    v = v.reshape(Bn, S, C_KV_HEADS, C_HEAD_DIM)
    o, _ = banded_attention(q, k, v, C_RADIUS, 1, alibi_slopes(C_HEADS).reshape(C_KV_HEADS, G),
                            sink.astype(jnp.float32).reshape(C_KV_HEADS, G))
    return o.reshape(Bn, S, C_MIX).astype(h.dtype) @ w_out


def setup_inputs(seed: int = 0) -> dict:
    key = jax.random.key(seed)
    ks = jax.random.split(key, 16)
    nrm = jax.random.normal
    D, F = D_MODEL, D_FF
    x = nrm(ks[0], (BATCH, SEQ, D), jnp.float32)
    norm_g = 1.0 + 0.02 * nrm(ks[1], (DEPTH, 3, D), jnp.float32)
    ffn_w1 = nrm(ks[2], (DEPTH, 2, D, F), jnp.float32) * D ** -0.5
    ffn_w3 = nrm(ks[3], (DEPTH, 2, D, F), jnp.float32) * D ** -0.5
    ffn_w2 = nrm(ks[4], (DEPTH, 2, F, D), jnp.float32) * F ** -0.5
    ab_w_in = nrm(ks[5], (N_EVEN, D, AB_IN), jnp.float32) * D ** -0.5
    ab_conv_w = nrm(ks[6], (N_EVEN, M_CONV, 2 * M_WIDTH), jnp.float32) * M_CONV ** -0.5
    ab_conv_b = 0.02 * nrm(ks[7], (N_EVEN, 2 * M_WIDTH), jnp.float32)
    ig_b = 0.1 * nrm(ks[8], (N_EVEN, 1, 2, M_HEADS), jnp.float32)
    fg_b = jnp.linspace(3.0, 6.0, M_HEADS, dtype=jnp.float32) + 0.1 * nrm(ks[9], (N_EVEN, 1, 2, M_HEADS), jnp.float32)
    ab_gate_b = jnp.concatenate([ig_b, fg_b], axis=1)
    ab_hnorm_g = 1.0 + 0.02 * nrm(ks[10], (N_EVEN, M_WIDTH), jnp.float32)
    ab_w_out = nrm(ks[11], (N_EVEN, AB_MIX, D), jnp.float32) * AB_MIX ** -0.5
    c_w_in = nrm(ks[12], (N_ODD, D, C_IN), jnp.float32) * D ** -0.5
    c_sink = 0.5 * nrm(ks[13], (N_ODD, C_HEADS), jnp.float32)
    c_w_out = nrm(ks[14], (N_ODD, C_MIX, D), jnp.float32) * C_MIX ** -0.5
    final_g = 1.0 + 0.02 * nrm(ks[15], (D,), jnp.float32)
    return {"x": x, "norm_g": norm_g, "ffn_w1": ffn_w1, "ffn_w3": ffn_w3, "ffn_w2": ffn_w2,
            "ab_w_in": ab_w_in, "ab_conv_w": ab_conv_w, "ab_conv_b": ab_conv_b, "ab_gate_b": ab_gate_b,
            "ab_hnorm_g": ab_hnorm_g, "ab_w_out": ab_w_out, "c_w_in": c_w_in, "c_sink": c_sink,
            "c_w_out": c_w_out, "final_g": final_g}


def reference(x, norm_g, ffn_w1, ffn_w3, ffn_w2, ab_w_in, ab_conv_w, ab_conv_b, ab_gate_b,
              ab_hnorm_g, ab_w_out, c_w_in, c_sink, c_w_out, final_g):
    for l in range(DEPTH):
        x = x + 0.5 * swiglu(rmsnorm(x, norm_g[l, 0]), ffn_w1[l, 0], ffn_w3[l, 0], ffn_w2[l, 0])
        h = rmsnorm(x, norm_g[l, 1])
        j = l // 2
        if l % 2 == 0:
            x = x + mixer_ab(h, ab_w_in[j], ab_conv_w[j], ab_conv_b[j], ab_gate_b[j], ab_hnorm_g[j], ab_w_out[j])
        else:
            x = x + mixer_c(h, c_w_in[j], c_sink[j], c_w_out[j])
        x = x + 0.5 * swiglu(rmsnorm(x, norm_g[l, 2]), ffn_w1[l, 1], ffn_w3[l, 1], ffn_w2[l, 1])
    return rmsnorm(x, final_g)
```

```cpp
#include <hip/hip_runtime.h>
#include <hip/hip_cooperative_groups.h>
#include <cstdio>
#include <cstdint>
namespace cg = cooperative_groups;

#ifndef MK_PER_PHASE
#define MK_PER_PHASE 0
#endif

#ifndef GEMM_REPS
#define GEMM_REPS 1
#endif
#ifndef DUPMASK
#define DUPMASK 0
#endif
#ifndef SYNC_REPS
#define SYNC_REPS 1
#endif
#ifndef PHMASK
#define PHMASK 0xffff
#endif
#define PHON(k) ((PHMASK >> (k)) & 1)
#define LAS __attribute__((address_space(3)))
#define GAS __attribute__((address_space(1)))
typedef unsigned short bf16_t;
typedef short bf16x8 __attribute__((ext_vector_type(8)));
typedef float f32x4 __attribute__((ext_vector_type(4)));
typedef float f32x2 __attribute__((ext_vector_type(2)));
typedef unsigned u32x4 __attribute__((ext_vector_type(4)));
typedef unsigned u32x2 __attribute__((ext_vector_type(2)));

constexpr int T = 16384, SEQ = 8192, D = 1024, FF = 2816, NUP = 2 * FF;
constexpr int AB_N = 3840, AB_LD = 3584, C_N = 1536;
constexpr int NTHREADS = 512;
constexpr float EPS = 1e-6f;
constexpr int PC_QK = 0, PC_V = 1024, PC_O = 1536, PC_QB = 2048, PC_KB = 2560, PC_VB = 3072;

constexpr size_t MiB = 1u << 20;
constexpr size_t W_UP_B = (size_t)NUP * D * 2, W_DN_B = (size_t)D * FF * 2, W_IN_B = (size_t)AB_N * D * 2, W_OUT_B = (size_t)D * D * 2;
constexpr size_t WS_WUP1 = 0, WS_WDN1 = WS_WUP1 + W_UP_B, WS_WUP2 = WS_WDN1 + W_DN_B, WS_WDN2 = WS_WUP2 + W_UP_B, WS_WIN = WS_WDN2 + W_DN_B, WS_WOUT = WS_WIN + W_IN_B;
static_assert(WS_WOUT + W_OUT_B <= 43 * MiB, "weights");
constexpr size_t WS_XB = 43 * MiB;
constexpr size_t WS_MIX = WS_XB + 32 * MiB;
constexpr size_t WS_BIG = WS_MIX + 32 * MiB;
constexpr size_t WS_GATES = WS_BIG + 112 * MiB;
constexpr size_t WS_SS = WS_GATES + 1 * MiB;
constexpr size_t WS_CST = WS_SS + 1 * MiB;
constexpr size_t WS_NST = WS_CST + 64 * MiB;
constexpr size_t WS_MSC = WS_NST + 1 * MiB;
constexpr size_t WS_OB = WS_MSC + 1 * MiB;
constexpr size_t WS_LSE = WS_OB + 48 * MiB;
constexpr size_t WS_END = WS_LSE + 2 * MiB;
static_assert(WS_END + 32768 <= 340 * MiB, "ws");

constexpr int LDS_BYTES = 147456;

__device__ __forceinline__ int tid_l() { int t = threadIdx.x; asm volatile("" : "+v"(t)); return t; }
typedef __bf16 bf16x2_t __attribute__((ext_vector_type(2)));
__device__ __forceinline__ unsigned cvt_pk_bf16(float lo, float hi) { const f32x2 v = {lo, hi}; const bf16x2_t b = __builtin_convertvector(v, bf16x2_t); return __builtin_bit_cast(unsigned, b); }
__device__ __forceinline__ float bf2f(unsigned h) { return __builtin_bit_cast(float, h << 16); }
__device__ __forceinline__ float bflo(unsigned w) { return __builtin_bit_cast(float, w << 16); }
__device__ __forceinline__ float bfhi(unsigned w) { return __builtin_bit_cast(float, w & 0xffff0000u); }
__device__ __forceinline__ float silu_f(float v) { return v * __builtin_amdgcn_rcpf(1.f + __expf(-v)); }
__device__ __forceinline__ float sigmoid_f(float v) { return __builtin_amdgcn_rcpf(1.f + __expf(-v)); }
typedef short s16x4 __attribute__((ext_vector_type(4)));
__device__ __forceinline__ u32x2 tr_read(const bf16_t* p) { const s16x4 r = __builtin_amdgcn_ds_read_tr16_b64_v4i16((LAS s16x4*)p); return __builtin_bit_cast(u32x2, r); }
__device__ __forceinline__ f32x4 mma16(bf16x8 a, bf16x8 b, f32x4 c) { return __builtin_amdgcn_mfma_f32_16x16x32_bf16(a, b, c, 0, 0, 0); }
__device__ __forceinline__ float rstd_of(const float* ss, int row) {
    const f32x4* p = (const f32x4*)(ss + (size_t)row * 16);
    const f32x4 a = p[0], b = p[1], c = p[2], d = p[3];
    const float s = ((a.x + a.y) + (a.z + a.w)) + ((b.x + b.y) + (b.z + b.w)) + ((c.x + c.y) + (c.z + c.w)) + ((d.x + d.y) + (d.z + d.w));
    return rsqrtf(s * (1.f / 1024.f) + EPS);
}
__device__ __forceinline__ float wave_sum(float v) {
#pragma unroll
    for (int o = 1; o < 64; o <<= 1) v += __shfl_xor(v, o);
    return v;
}
__device__ __forceinline__ float incl_sum(float v, int lane) {
#pragma unroll
    for (int o = 1; o < 64; o <<= 1) { const float t = __shfl_up(v, o); if (lane >= o) v += t; }
    return v;
}
__device__ __forceinline__ float incl_max(float v, int lane) {
#pragma unroll
    for (int o = 1; o < 64; o <<= 1) { const float t = __shfl_up(v, o); if (lane >= o) v = fmaxf(v, t); }
    return v;
}

namespace pg8 {
constexpr int BM = 256, BK = 64, HALF = 128, HTB = HALF * BK * 2, STAGE_BYTES = 8 * HTB, NXCD = 8, WGM = 8;
__host__ __device__ __forceinline__ int lds_byte(int r, int c) { const int st = (r >> 4) * 2 + (c >> 5), rr = r & 15, cc = c & 31, ob = rr * 64 + cc * 2; return st * 1024 + (ob ^ (((ob >> 9) & 1) << 5)); }
__host__ __device__ __forceinline__ void stage_rc(int b, int& R, int& C) { const int st = b / 1024, sb = b % 1024, swz = sb ^ (((sb >> 9) & 1) << 5); R = (st >> 1) * 16 + swz / 64; C = (st & 1) * 32 + (swz % 64) / 2; }
__host__ __device__ __forceinline__ int perm32(int rho) { const int n = rho >> 4, i = rho & 15; return 8 * (i >> 2) + 4 * n + (i & 3); }
struct Unit { int pm, pn, idx; };
struct Gemm { const bf16_t* A; const bf16_t* Bt; int M, N, K; };
struct StaticOrder {
    int nM, nN, nwg, G, c;
    __host__ __device__ void init(int M, int N, int G_, int c_) { nM = M / BM; nN = N / BM; nwg = nM * nN; G = G_; c = c_; }
    __host__ __device__ bool next(int i, Unit& u) const {
        const long L = (long)i * G + c; if (L >= nwg) return false;
        int wgid = (int)L; { const int q = nwg / NXCD, r = nwg % NXCD, xcd = wgid % NXCD, off = wgid / NXCD; wgid = (xcd < r ? xcd * (q + 1) : r * (q + 1) + (xcd - r) * q) + off; }
        const int nig = WGM * nN, gid = wgid / nig, fm = gid * WGM, gsz = (nM - fm) < WGM ? (nM - fm) : WGM;
        u.pm = fm + ((wgid % nig) % gsz); u.pn = (wgid % nig) / gsz; u.idx = i; return true;
    }
    __device__ __forceinline__ void a_ready(const Unit&) const {}
    __device__ __forceinline__ void done(const Unit&) const {}
};


struct EpiUp {
    static constexpr bool PERM = true, AFTER_DRAIN = false;
    bf16_t* H; LAS const float* rtab;
    __device__ __forceinline__ void operator()(const f32x4 (&acc)[2][2][4][2], const Unit& u, int wr, int wc, int fr, int fq) const {
        const int row0 = u.pm * BM + wr * 64 + fr, col0 = u.pn * 128 + wc * 32 + 8 * fq;
#pragma unroll
        for (int ai = 0; ai < 2; ++ai)
#pragma unroll
            for (int m = 0; m < 4; ++m) {
                const int row = row0 + ai * HALF + m * 16; const float r = rtab[u.idx * 256 + ai * HALF + wr * 64 + m * 16 + fr];
                unsigned wv[4];
#pragma unroll
                for (int n = 0; n < 2; ++n) { const f32x4 a = acc[ai][0][m][n] * r, b = acc[ai][1][m][n] * r;
                    wv[2 * n] = cvt_pk_bf16(silu_f(a[0]) * b[0], silu_f(a[1]) * b[1]); wv[2 * n + 1] = cvt_pk_bf16(silu_f(a[2]) * b[2], silu_f(a[3]) * b[3]); }
                const u32x4 w = (u32x4){wv[0], wv[1], wv[2], wv[3]};
                *(u32x4*)(H + (size_t)row * FF + col0) = w;
                __builtin_amdgcn_sched_barrier(0);
            }
    }
};
struct EpiRes {
    static constexpr bool PERM = true, AFTER_DRAIN = false;
    GAS const float* base; GAS float* out; bf16_t* xb; float* ss; float scale;
    __device__ __forceinline__ void operator()(const f32x4 (&acc)[2][2][4][2], const Unit& u, int wr, int wc, int fr, int fq) const {
        const int row0 = u.pm * BM + wr * 64 + fr, col0 = u.pn * BM + wc * 32 + 8 * fq;
#pragma unroll
        for (int ai = 0; ai < 2; ++ai)
#pragma unroll
          for (int mh = 0; mh < 2; ++mh) {
            f32x4 bs[2][2][2];
#pragma unroll
            for (int mi = 0; mi < 2; ++mi) { const size_t off = (size_t)(row0 + ai * HALF + (2 * mh + mi) * 16) * D + col0;
#pragma unroll
                for (int bj = 0; bj < 2; ++bj)
#pragma unroll
                    for (int n = 0; n < 2; ++n) bs[mi][bj][n] = *(GAS const f32x4*)(base + off + bj * HALF + n * 4); }
#pragma unroll
            for (int mi = 0; mi < 2; ++mi) {
                const int m = 2 * mh + mi;
                const int row = row0 + ai * HALF + m * 16; const size_t off = (size_t)row * D + col0; float sq = 0.f;
#pragma unroll
                for (int bj = 0; bj < 2; ++bj) {
                    const f32x4 o0 = bs[mi][bj][0] + acc[ai][bj][m][0] * scale, o1 = bs[mi][bj][1] + acc[ai][bj][m][1] * scale;
                    *(GAS f32x4*)(out + off + bj * HALF) = o0; *(GAS f32x4*)(out + off + bj * HALF + 4) = o1;
                    u32x4 w; w.x = cvt_pk_bf16(o0[0], o0[1]); w.y = cvt_pk_bf16(o0[2], o0[3]); w.z = cvt_pk_bf16(o1[0], o1[1]); w.w = cvt_pk_bf16(o1[2], o1[3]);
                    *(u32x4*)(xb + off + bj * HALF) = w;
                    sq += ((o0[0] * o0[0] + o0[1] * o0[1]) + (o0[2] * o0[2] + o0[3] * o0[3])) + ((o1[0] * o1[0] + o1[1] * o1[1]) + (o1[2] * o1[2] + o1[3] * o1[3]));
                }
                sq += __shfl_xor(sq, 16); sq += __shfl_xor(sq, 32);
                if (fq == 0) ss[(size_t)row * 16 + u.pn * 4 + wc] = sq;
            }
          }
    }
};
struct EpiProj {
    static constexpr bool PERM = true, AFTER_DRAIN = false;
    bf16_t* O; int ldc; LAS const float* rtab; float* gates; int gate_pn;
    __device__ __forceinline__ void operator()(const f32x4 (&acc)[2][2][4][2], const Unit& u, int wr, int wc, int fr, int fq) const {
        const int row0 = u.pm * BM + wr * 64 + fr, col0 = u.pn * BM + wc * 32 + 8 * fq;
#pragma unroll
        for (int ai = 0; ai < 2; ++ai)
#pragma unroll
            for (int m = 0; m < 4; ++m) {
                const int row = row0 + ai * HALF + m * 16; const float r = rtab[u.idx * 256 + ai * HALF + wr * 64 + m * 16 + fr];
                if (u.pn == gate_pn) {
                    if (wc == 0 && fq < 2) { float* g = gates + (size_t)row * 16 + 8 * fq; *(f32x4*)g = acc[ai][0][m][0] * r; *(f32x4*)(g + 4) = acc[ai][0][m][1] * r; }
                } else {
                    bf16_t* rowp = O + (size_t)row * ldc + col0;
#pragma unroll
                    for (int bj = 0; bj < 2; ++bj) { const f32x4 v0 = acc[ai][bj][m][0] * r, v1 = acc[ai][bj][m][1] * r;
                        u32x4 w; w.x = cvt_pk_bf16(v0[0], v0[1]); w.y = cvt_pk_bf16(v0[2], v0[3]); w.z = cvt_pk_bf16(v1[0], v1[1]); w.w = cvt_pk_bf16(v1[2], v1[3]);
                        *(u32x4*)(rowp + bj * HALF) = w; }
                }
            }
    }
};

template <class Epi, class Sched, bool ALIGN_EPI = false, bool SP2 = false>
__device__ __forceinline__ void gemm_phase(LAS unsigned char* lds, const Gemm g, const Sched& S, const Epi& E) {
    const int tid = tid_l(), wid = __builtin_amdgcn_readfirstlane(tid >> 6), lane = tid & 63, wr = wid >> 2, wc = wid & 3, fr = lane & 15, fq = lane >> 4;
    const int K = g.K, nt = K / BK;
    unsigned voffA[2], voffB[2];
#pragma unroll
    for (int i = 0; i < 2; ++i) { int R, C; stage_rc(tid * 16 + i * 8192, R, C); const int Rb = Epi::PERM ? ((R & ~31) + perm32(R & 31)) : R;
        voffA[i] = (unsigned)(R * K + C) * 2u; voffB[i] = (unsigned)(Rb * K + C) * 2u; }
    const size_t kstep = (size_t)(BK * 2);
    const size_t hstep = (size_t)HALF * K * 2;
    const size_t tstep = 2 * hstep;
    const unsigned ldsw = (unsigned)wid * 1024u;
    const int aoff = lds_byte(wr * 64 + fr, fq * 8), boff = lds_byte(wc * 32 + fr, fq * 8);
#define PG8_SA(b, h) (((b) * 2 + (h)) * HTB)
#define PG8_SB(b, h) ((4 + (b) * 2 + (h)) * HTB)
#define PG8_STAGE(bufoff, gbase, voff) do { _Pragma("unroll") for (int _i = 0; _i < 2; ++_i) \
        __builtin_amdgcn_global_load_lds((const unsigned*)((const char*)(gbase) + (voff)[_i]), (LAS unsigned*)(lds + (bufoff) + ldsw + _i * 8192), 16, 0, 0); } while (0)
#define PG8_LDA(dst, b, h) do { _Pragma("unroll") for (int m = 0; m < 4; ++m) _Pragma("unroll") for (int k = 0; k < 2; ++k) dst[m][k] = *(const LAS bf16x8*)(lds + PG8_SA(b, h) + aoff + m * 2048 + k * 1024); } while (0)
#define PG8_LDB(dst, b, h) do { _Pragma("unroll") for (int n = 0; n < 2; ++n) _Pragma("unroll") for (int k = 0; k < 2; ++k) dst[n][k] = *(const LAS bf16x8*)(lds + PG8_SB(b, h) + boff + n * 2048 + k * 1024); } while (0)
#define PG8_MMA(ai, bj, At, Bt) do { __builtin_amdgcn_s_setprio(1); _Pragma("unroll") for (int m = 0; m < 4; ++m) _Pragma("unroll") for (int n = 0; n < 2; ++n) _Pragma("unroll") for (int k = 0; k < 2; ++k) \
        acc[ai][bj][m][n] = __builtin_amdgcn_mfma_f32_16x16x32_bf16(Bt[n][k], At[m][k], acc[ai][bj][m][n], 0, 0, 0); __builtin_amdgcn_s_setprio(0); } while (0)
#define PG8_WAIT_V(n) asm volatile("s_waitcnt vmcnt(" #n ")" ::: "memory")
#define PG8_WAIT_L(n) asm volatile("s_waitcnt lgkmcnt(" #n ")" ::: "memory")
#define PG8_BAR __builtin_amdgcn_s_barrier()
#define PG8_SCHED __builtin_amdgcn_sched_barrier(0)
    Unit cur, nxt; int ui = 0;
    if (!S.next(0, cur)) return;
    f32x4 acc[2][2][4][2];
#pragma unroll
    for (int a = 0; a < 2; ++a)
#pragma unroll
        for (int b = 0; b < 2; ++b)
#pragma unroll
            for (int m = 0; m < 4; ++m)
#pragma unroll
                for (int n = 0; n < 2; ++n) acc[a][b][m][n] = (f32x4){0.f, 0.f, 0.f, 0.f};
    bf16x8 At[4][2], B0[2][2], B1[2][2];
    const char* cA = (const char*)g.A + (size_t)cur.pm * tstep; const char* cB = (const char*)g.Bt + (size_t)cur.pn * tstep;
    S.a_ready(cur);
    if constexpr (SP2) {
        PG8_STAGE(PG8_SB(0, 0), cB, voffB); PG8_STAGE(PG8_SB(0, 1), cB + hstep, voffB); PG8_STAGE(PG8_SA(0, 0), cA, voffA); PG8_STAGE(PG8_SA(0, 1), cA + hstep, voffA);
        if (wr == 1) PG8_BAR;
        PG8_WAIT_V(2); PG8_BAR;
        PG8_STAGE(PG8_SB(1, 0), cB + kstep, voffB); PG8_STAGE(PG8_SA(1, 0), cA + kstep, voffA); PG8_STAGE(PG8_SB(1, 1), cB + hstep + kstep, voffB);
        PG8_WAIT_V(6); PG8_BAR;
    } else {
        PG8_STAGE(PG8_SB(0, 0), cB, voffB); PG8_STAGE(PG8_SA(0, 0), cA, voffA); PG8_STAGE(PG8_SB(0, 1), cB + hstep, voffB); PG8_STAGE(PG8_SA(0, 1), cA + hstep, voffA);
        if (wr == 1) PG8_BAR;
        PG8_WAIT_V(4); PG8_BAR;
        PG8_STAGE(PG8_SB(1, 0), cB + kstep, voffB); PG8_STAGE(PG8_SA(1, 0), cA + kstep, voffA); PG8_STAGE(PG8_SB(1, 1), cB + hstep + kstep, voffB);
        PG8_WAIT_V(6); PG8_BAR;
    }
    for (;;) {
        const bool has_next = S.next(ui + 1, nxt);
        const char* nA = has_next ? (const char*)g.A + (size_t)nxt.pm * tstep : cA; const char* nB = has_next ? (const char*)g.Bt + (size_t)nxt.pn * tstep : cB;
        for (int t = 0; t < nt; t += 2) {
            const bool last = (t == nt - 2);
            const char* a1 = cA + (size_t)(t + 1) * kstep;
            const char* a2 = last ? nA : cA + (size_t)(t + 2) * kstep; const char* b2 = last ? nB : cB + (size_t)(t + 2) * kstep;
            const char* a3 = a2 + kstep; const char* b3 = b2 + kstep;
            if (last && has_next) S.a_ready(nxt);
            if constexpr (SP2) {
            PG8_LDB(B0, 0, 0); PG8_LDB(B1, 0, 1); PG8_SCHED; PG8_LDA(At, 0, 0); PG8_STAGE(PG8_SA(1, 1), a1 + hstep, voffA);
            PG8_WAIT_V(8); PG8_WAIT_L(0); PG8_BAR; PG8_MMA(0, 0, At, B0); PG8_MMA(0, 1, At, B1); PG8_BAR; PG8_SCHED;
            PG8_LDA(At, 0, 1); PG8_STAGE(PG8_SB(0, 0), b2, voffB); PG8_STAGE(PG8_SB(0, 1), b2 + hstep, voffB); PG8_STAGE(PG8_SA(0, 0), a2, voffA);
            PG8_WAIT_V(8); PG8_WAIT_L(0); PG8_BAR; PG8_MMA(1, 0, At, B0); PG8_MMA(1, 1, At, B1); PG8_BAR; PG8_SCHED;
            PG8_LDB(B0, 1, 0); PG8_LDB(B1, 1, 1); PG8_SCHED; PG8_LDA(At, 1, 0); PG8_STAGE(PG8_SA(0, 1), a2 + hstep, voffA);
            PG8_WAIT_V(8); PG8_WAIT_L(0); PG8_BAR; PG8_MMA(0, 0, At, B0); PG8_MMA(0, 1, At, B1); PG8_BAR; PG8_SCHED;
            PG8_LDA(At, 1, 1); PG8_STAGE(PG8_SB(1, 0), b3, voffB); PG8_STAGE(PG8_SB(1, 1), b3 + hstep, voffB); PG8_STAGE(PG8_SA(1, 0), a3, voffA);
            PG8_WAIT_V(8); PG8_WAIT_L(0); PG8_BAR; PG8_MMA(1, 0, At, B0); PG8_MMA(1, 1, At, B1); PG8_BAR; PG8_SCHED;
            } else {
            PG8_LDB(B0, 0, 0); PG8_SCHED; PG8_LDA(At, 0, 0); PG8_STAGE(PG8_SA(1, 1), a1 + hstep, voffA);
            PG8_WAIT_L(8); PG8_BAR; PG8_WAIT_L(0); PG8_MMA(0, 0, At, B0); PG8_BAR; PG8_SCHED;
            PG8_LDB(B1, 0, 1); PG8_STAGE(PG8_SB(0, 0), b2, voffB);
            PG8_BAR; PG8_WAIT_L(0); PG8_MMA(0, 1, At, B1); PG8_BAR;
            PG8_LDA(At, 0, 1); PG8_STAGE(PG8_SA(0, 0), a2, voffA);
            PG8_BAR; PG8_WAIT_L(0); PG8_MMA(1, 0, At, B0); PG8_BAR; PG8_SCHED;
            PG8_STAGE(PG8_SB(0, 1), b2 + hstep, voffB);
            PG8_WAIT_V(6); PG8_BAR; PG8_MMA(1, 1, At, B1); PG8_BAR;
            PG8_LDB(B0, 1, 0); PG8_SCHED; PG8_LDA(At, 1, 0); PG8_STAGE(PG8_SA(0, 1), a2 + hstep, voffA);
            PG8_WAIT_L(8); PG8_BAR; PG8_WAIT_L(0); PG8_MMA(0, 0, At, B0); PG8_BAR; PG8_SCHED;
            PG8_LDB(B1, 1, 1); PG8_STAGE(PG8_SB(1, 0), b3, voffB);
            PG8_BAR; PG8_WAIT_L(0); PG8_MMA(0, 1, At, B1); PG8_BAR;
            PG8_LDA(At, 1, 1); PG8_STAGE(PG8_SA(1, 0), a3, voffA);
            PG8_BAR; PG8_WAIT_L(0); PG8_MMA(1, 0, At, B0); PG8_BAR; PG8_SCHED;
            PG8_STAGE(PG8_SB(1, 1), b3 + hstep, voffB);
            PG8_WAIT_V(6); PG8_BAR; PG8_MMA(1, 1, At, B1); PG8_BAR;
            }
        }
        if constexpr (ALIGN_EPI) { if (wr == 0) PG8_BAR; }
        if constexpr (!Epi::AFTER_DRAIN) { E(acc, cur, wr, wc, fr, fq); S.done(cur); }
        if (!has_next) break;
#pragma unroll
        for (int a = 0; a < 2; ++a)
#pragma unroll
            for (int b = 0; b < 2; ++b)
#pragma unroll
                for (int m = 0; m < 4; ++m)
#pragma unroll
                    for (int n = 0; n < 2; ++n) acc[a][b][m][n] = (f32x4){0.f, 0.f, 0.f, 0.f};
        cur = nxt; cA = nA; cB = nB; ++ui;
        if constexpr (ALIGN_EPI) { if (wr == 1) PG8_BAR; }
    }
    PG8_WAIT_V(0);
    if constexpr (!ALIGN_EPI) { if (wr == 0) PG8_BAR; }
    PG8_BAR;
#undef PG8_SA
#undef PG8_SB
#undef PG8_STAGE
#undef PG8_LDA
#undef PG8_LDB
#undef PG8_MMA
#undef PG8_WAIT_V
#undef PG8_WAIT_L
#undef PG8_BAR
#undef PG8_SCHED
}
constexpr int LDS_RTAB = STAGE_BYTES;
__device__ __forceinline__ void fill_rstd(LAS unsigned char* lds, const float* ss, const StaticOrder& S) {
    LAS float* tab = (LAS float*)(lds + LDS_RTAB);
    const int tid = tid_l(), rl = tid >> 1, half = tid & 1;
#pragma unroll 1
    for (int i = 0; i < 8; ++i) {
        Unit u; if (!S.next(i, u)) break;
        const f32x4* p = (const f32x4*)(ss + (size_t)(u.pm * BM + rl) * 16 + half * 8);
        const f32x4 a = p[0], b = p[1];
        float sm = ((a.x + a.y) + (a.z + a.w)) + ((b.x + b.y) + (b.z + b.w));
        sm += __shfl_xor(sm, 1);
        if (half == 0) tab[i * 256 + rl] = rsqrtf(sm * (1.f / 1024.f) + EPS);
    }
    __syncthreads();
}
}

struct Args {
    const float* in[15]; float* out; unsigned char* ws; int ph_lo, ph_hi;
};
struct Ctx { unsigned char* ws; int G, bid; };
constexpr size_t WS_TAB = WS_END;
#define INP(k) ((const float*)(GAS const float*)(((const float* const*)(X.ws + WS_TAB))[k]))
#define X_x INP(0)
#define X_norm_g INP(1)
#define X_w1 INP(2)
#define X_w3 INP(3)
#define X_w2 INP(4)
#define X_ab_w_in INP(5)
#define X_ab_conv_w INP(6)
#define X_ab_conv_b INP(7)
#define X_ab_gate_b INP(8)
#define X_ab_hnorm_g INP(9)
#define X_ab_w_out INP(10)
#define X_c_w_in INP(11)
#define X_c_sink INP(12)
#define X_c_w_out INP(13)
#define X_final_g INP(14)
#define X_out ((float*)(GAS float*)(((float* const*)(X.ws + WS_TAB))[15]))
#define WSP(TY, off) ((TY*)(X.ws + (off)))
#define X_Wup1 WSP(bf16_t, WS_WUP1)
#define X_Wdn1 WSP(bf16_t, WS_WDN1)
#define X_Wup2 WSP(bf16_t, WS_WUP2)
#define X_Wdn2 WSP(bf16_t, WS_WDN2)
#define X_Win WSP(bf16_t, WS_WIN)
#define X_Wout WSP(bf16_t, WS_WOUT)
#define X_xb WSP(bf16_t, WS_XB)
#define X_mix WSP(bf16_t, WS_MIX)
#define X_big WSP(bf16_t, WS_BIG)
#define X_qc WSP(bf16_t, WS_XB)
#define X_kc WSP(bf16_t, WS_XB + (size_t)T * 512 * 2)
#define X_cst WSP(bf16_t, WS_CST)
#define X_ob WSP(bf16_t, WS_OB)
#define X_gates WSP(float, WS_GATES)
#define X_ss WSP(float, WS_SS)
#define X_nst WSP(float, WS_NST)
#define X_mc WSP(float, WS_MSC)
#define X_bc WSP(float, WS_MSC + 8192)
#define X_mprev WSP(float, WS_MSC + 16384)
#define X_lse WSP(float, WS_LSE)

__device__ __forceinline__ int wrow_map(int mode, int n) {
    if (mode == 1) return ((n >> 7) << 8) + (n & 127);
    if (mode == 2) return ((n >> 7) << 8) + 128 + (n & 127);
    if (mode == 3) return n < 2048 ? n : (n < 2064 ? 3584 + (n - 2048) : n - 16);
    return n;
}
__device__ __forceinline__ void transpose_item(const float* Wg, int K, int N, bf16_t* WT, int mode, const float* gg, float* scr, int item, int lane) {
    GAS const float* W = (GAS const float*)Wg; GAS const float* g = (GAS const float*)gg;
    const int nblk = (N + 63) >> 6, kb = item / nblk, nb = item - kb * nblk, k0 = 64 * kb, n0 = 64 * nb;
    const int c4 = 4 * (lane & 15), rr = lane >> 4; const bool colok = (n0 + c4) < N;
    f32x4 v[16];
#pragma unroll
    for (int i = 0; i < 16; ++i) { v[i] = (f32x4){0.f, 0.f, 0.f, 0.f}; if (colok) v[i] = *(GAS const f32x4*)(W + (size_t)(k0 + 4 * i + rr) * N + n0 + c4); }
    if (gg) {
#pragma unroll
        for (int i = 0; i < 16; ++i) v[i] = v[i] * g[k0 + 4 * i + rr];
    }
#pragma unroll
    for (int i = 0; i < 16; ++i) *(f32x4*)(scr + (4 * i + rr) * 68 + c4) = v[i];
    asm volatile("s_waitcnt lgkmcnt(0)" ::: "memory");
    const int c = lane & 7;
#pragma unroll
    for (int j = 0; j < 8; ++j) { const int n = (lane >> 3) + 8 * j; const float* sp = scr + (8 * c) * 68 + n;
        if (n0 + n < N) {
            u32x4 o; o.x = cvt_pk_bf16(sp[0 * 68], sp[1 * 68]); o.y = cvt_pk_bf16(sp[2 * 68], sp[3 * 68]); o.z = cvt_pk_bf16(sp[4 * 68], sp[5 * 68]); o.w = cvt_pk_bf16(sp[6 * 68], sp[7 * 68]);
            *(u32x4*)(WT + (size_t)wrow_map(mode, n0 + n) * K + k0 + 8 * c) = o; } }
    asm volatile("s_waitcnt lgkmcnt(0)" ::: "memory");
}
__device__ __forceinline__ void phase_convert(unsigned char* lds, const Ctx& X, int l, int parts, int gwg, int nwg_part) {
    const int tid = tid_l(), lane = tid & 63, wave = tid >> 6;
    float* scr = (float*)(lds + wave * 17408);
    const int gw = gwg * 8 + wave, NGW = nwg_part * 8;
    const int j = l >> 1; const bool even = (l & 1) == 0;
    constexpr int I_UP = (D / 64) * (FF / 64), I_DN = (FF / 64) * (D / 64);
    const int Nin = even ? 3600 : C_N; const int I_IN = (D / 64) * ((Nin + 63) / 64); constexpr int I_OUT = (D / 64) * (D / 64);
    const int NA = (parts & 1) ? (2 * I_UP + I_DN + I_IN + I_OUT) : 0, NB = (parts & 2) ? (2 * I_UP + I_DN) : 0;
    const float* g0 = X_norm_g + (size_t)(l * 3 + 0) * D; const float* g1 = X_norm_g + (size_t)(l * 3 + 1) * D; const float* g2 = X_norm_g + (size_t)(l * 3 + 2) * D;
    const size_t wff = (size_t)D * FF;
    for (int it = gw; it < NA + NB; it += NGW) {
        int r = it;
        if (r < NA) {
            if (r < I_UP) { transpose_item(X_w1 + (size_t)(l * 2 + 0) * wff, D, FF, X_Wup1, 1, g0, scr, r, lane); continue; } r -= I_UP;
            if (r < I_UP) { transpose_item(X_w3 + (size_t)(l * 2 + 0) * wff, D, FF, X_Wup1, 2, g0, scr, r, lane); continue; } r -= I_UP;
            if (r < I_DN) { transpose_item(X_w2 + (size_t)(l * 2 + 0) * wff, FF, D, X_Wdn1, 0, nullptr, scr, r, lane); continue; } r -= I_DN;
            if (r < I_IN) { if (even) transpose_item(X_ab_w_in + (size_t)j * D * 3600, D, 3600, X_Win, 3, g1, scr, r, lane);
                            else transpose_item(X_c_w_in + (size_t)j * D * C_N, D, C_N, X_Win, 0, g1, scr, r, lane); continue; } r -= I_IN;
            transpose_item((even ? X_ab_w_out : X_c_w_out) + (size_t)j * D * D, D, D, X_Wout, 0, nullptr, scr, r, lane); continue;
        }
        r -= NA;
        if (r < I_UP) { transpose_item(X_w1 + (size_t)(l * 2 + 1) * wff, D, FF, X_Wup2, 1, g2, scr, r, lane); continue; } r -= I_UP;
        if (r < I_UP) { transpose_item(X_w3 + (size_t)(l * 2 + 1) * wff, D, FF, X_Wup2, 2, g2, scr, r, lane); continue; } r -= I_UP;
        transpose_item(X_w2 + (size_t)(l * 2 + 1) * wff, FF, D, X_Wdn2, 0, nullptr, scr, r, lane);
    }
    if (even && (parts & 1)) {
        u32x4* z = (u32x4*)(X_Win + (size_t)3600 * D); const int n16 = 240 * D * 2 / 16;
        for (int i = gwg * NTHREADS + tid; i < n16; i += nwg_part * NTHREADS) z[i] = (u32x4){0u, 0u, 0u, 0u};
    }
}
__device__ __forceinline__ void convert_in_tail(unsigned char* lds, const Ctx& X, int l, int parts, int nunits) {
    const int rounds = (nunits + X.G - 1) / X.G; const int n_full = nunits - (rounds - 1) * X.G;
    if (n_full >= X.G) { phase_convert(lds, X, l, parts, X.bid, X.G); return; }
    if (X.bid >= n_full) phase_convert(lds, X, l, parts, X.bid - n_full, X.G - n_full);
}
__device__ __forceinline__ void phase_init(const Ctx& X) {
    const int tid = tid_l(), lane = tid & 63, wave = tid >> 6;
    const int gw = X.bid * 8 + wave, NGW = X.G * 8;
    for (int m = gw; m < T; m += NGW) {
        GAS const f32x4* xr = (GAS const f32x4*)(X_x + (size_t)m * D) + lane; u32x2* o8 = (u32x2*)(X_xb + (size_t)m * D) + lane; float s = 0.f;
#pragma unroll
        for (int j = 0; j < 4; ++j) { const f32x4 v = xr[64 * j]; s += (v.x * v.x + v.y * v.y) + (v.z * v.z + v.w * v.w); u32x2 w; w.x = cvt_pk_bf16(v.x, v.y); w.y = cvt_pk_bf16(v.z, v.w); o8[64 * j] = w; }
        s = wave_sum(s);
        if (lane < 16) X_ss[(size_t)m * 16 + lane] = lane == 0 ? s : 0.f;
    }
}
__device__ __forceinline__ void phase_final(const Ctx& X) {
    const int tid = tid_l(), lane = tid & 63, wave = tid >> 6;
    const int gw = X.bid * 8 + wave, NGW = X.G * 8;
    GAS const f32x4* gr = (GAS const f32x4*)X_final_g + lane;
    for (int m = gw; m < T; m += 2 * NGW) {
        const int m2 = (m + NGW < T) ? m + NGW : m;
        GAS f32x4* xa = (GAS f32x4*)(X_out + (size_t)m * D) + lane; GAS f32x4* xc = (GAS f32x4*)(X_out + (size_t)m2 * D) + lane;
        f32x4 va[4], vc[4]; float sa = 0.f, sc = 0.f;
#pragma unroll
        for (int j = 0; j < 4; ++j) { va[j] = xa[64 * j]; vc[j] = xc[64 * j]; }
#pragma unroll
        for (int j = 0; j < 4; ++j) { sa += (va[j].x * va[j].x + va[j].y * va[j].y) + (va[j].z * va[j].z + va[j].w * va[j].w); sc += (vc[j].x * vc[j].x + vc[j].y * vc[j].y) + (vc[j].z * vc[j].z + vc[j].w * vc[j].w); }
        const float ra = rsqrtf(wave_sum(sa) * (1.f / 1024.f) + EPS), rc = rsqrtf(wave_sum(sc) * (1.f / 1024.f) + EPS);
#pragma unroll
        for (int j = 0; j < 4; ++j) { const f32x4 g = gr[64 * j]; xa[64 * j] = va[j] * ra * g; if (m2 != m) xc[64 * j] = vc[j] * rc * g; }
    }
}

__device__ __forceinline__ void phase_conv(const Ctx& X, int j) {
    const float* cw = X_ab_conv_w + (size_t)j * 5 * 1024; const float* cb = X_ab_conv_b + (size_t)j * 1024;
    const int nitems = T * 128;
    const int idx0 = X.bid * NTHREADS + tid_l(); const int step = X.G * NTHREADS;
    if ((step & 127) == 0) {
        const int c0 = (idx0 & 127) * 8; const bool isk = c0 >= 512; const float sc = isk ? 0.08838834764831845f : 1.f;
        f32x4 w0[5], w1[5];
#pragma unroll
        for (int k = 0; k < 5; ++k) { w0[k] = *(const f32x4*)(cw + k * 1024 + c0); w1[k] = *(const f32x4*)(cw + k * 1024 + c0 + 4); }
        const f32x4 b0 = *(const f32x4*)(cb + c0), b1 = *(const f32x4*)(cb + c0 + 4);
        for (int idx = idx0; idx < nitems; idx += step) {
            const int t = idx >> 7, tt = t & (SEQ - 1);
            u32x4 v[5];
#pragma unroll
            for (int k = 0; k < 5; ++k) { const int tp = tt + k - 2; v[k] = (u32x4){0u, 0u, 0u, 0u}; if (tp >= 0 && tp < SEQ) v[k] = *(const u32x4*)(X_big + (size_t)(t + k - 2) * AB_LD + PC_QK + c0); }
            float a[8] = {b0.x, b0.y, b0.z, b0.w, b1.x, b1.y, b1.z, b1.w};
#pragma unroll
            for (int k = 0; k < 5; ++k) {
                a[0] += bflo(v[k].x) * w0[k].x; a[1] += bfhi(v[k].x) * w0[k].y; a[2] += bflo(v[k].y) * w0[k].z; a[3] += bfhi(v[k].y) * w0[k].w;
                a[4] += bflo(v[k].z) * w1[k].x; a[5] += bfhi(v[k].z) * w1[k].y; a[6] += bflo(v[k].w) * w1[k].z; a[7] += bfhi(v[k].w) * w1[k].w;
            }
#pragma unroll
            for (int i = 0; i < 8; ++i) a[i] = silu_f(a[i]) * sc;
            u32x4 o; o.x = cvt_pk_bf16(a[0], a[1]); o.y = cvt_pk_bf16(a[2], a[3]); o.z = cvt_pk_bf16(a[4], a[5]); o.w = cvt_pk_bf16(a[6], a[7]);
            bf16_t* dst = isk ? (X_kc + (size_t)t * 512 + (c0 - 512)) : (X_qc + (size_t)t * 512 + c0);
            *(u32x4*)dst = o;
        }
        return;
    }
    for (int idx = idx0; idx < nitems; idx += step) {
        const int t = idx >> 7, c0 = (idx & 127) * 8, tt = t & (SEQ - 1);
        float a[8];
#pragma unroll
        for (int i = 0; i < 8; ++i) a[i] = cb[c0 + i];
#pragma unroll
        for (int k = 0; k < 5; ++k) {
            const int tp = tt + k - 2;
            if (tp >= 0 && tp < SEQ) {
                const u32x4 v = *(const u32x4*)(X_big + (size_t)(t + k - 2) * AB_LD + PC_QK + c0);
                const f32x4 w0 = *(const f32x4*)(cw + k * 1024 + c0), w1 = *(const f32x4*)(cw + k * 1024 + c0 + 4);
                a[0] += bflo(v.x) * w0.x; a[1] += bfhi(v.x) * w0.y; a[2] += bflo(v.y) * w0.z; a[3] += bfhi(v.y) * w0.w;
                a[4] += bflo(v.z) * w1.x; a[5] += bfhi(v.z) * w1.y; a[6] += bflo(v.w) * w1.z; a[7] += bfhi(v.w) * w1.w;
            }
        }
        const bool isk = c0 >= 512; const float sc = isk ? 0.08838834764831845f : 1.f;
#pragma unroll
        for (int i = 0; i < 8; ++i) a[i] = silu_f(a[i]) * sc;
        u32x4 o; o.x = cvt_pk_bf16(a[0], a[1]); o.y = cvt_pk_bf16(a[2], a[3]); o.z = cvt_pk_bf16(a[4], a[5]); o.w = cvt_pk_bf16(a[6], a[7]);
        bf16_t* dst = isk ? (X_kc + (size_t)t * 512 + (c0 - 512)) : (X_qc + (size_t)t * 512 + c0);
        *(u32x4*)dst = o;
    }
}

struct AttnDesc { int row_base, dil, L, l0, hsel, di; };
template <bool ISB> struct AttnPtr {
    static __device__ __forceinline__ const bf16_t* Q(const Ctx& X, const AttnDesc& d) { return ISB ? X_big + PC_QB + d.hsel * 64 : X_big + d.hsel * 256; }
    static __device__ __forceinline__ const bf16_t* K(const Ctx& X, const AttnDesc& d) { return ISB ? X_big + PC_KB + d.hsel * 64 : X_big + 1024 + d.hsel * 64; }
    static __device__ __forceinline__ const bf16_t* V(const Ctx& X, const AttnDesc& d) { return ISB ? X_big + PC_VB + d.hsel * 64 : X_big + 1280 + d.hsel * 64; }
    static __device__ __forceinline__ bf16_t* O(const Ctx& X, const AttnDesc& d) { return ISB ? X_ob + (size_t)d.di * T * 512 + d.hsel * 64 : X_mix + d.hsel * 256; }
    static __device__ __forceinline__ float* LSE(const Ctx& X, const AttnDesc& d) { return X_lse + (size_t)d.di * T * 8 + d.hsel; }
    static constexpr int ldq = ISB ? AB_LD : C_N, ldkv = ldq, ldo = ISB ? 512 : 1024;
    static __device__ __forceinline__ int head0(const AttnDesc& d) { return ISB ? d.hsel : d.hsel * 4; }
};
template <int RAD> struct AttnGeo {
    static constexpr int NKS = (2 * RAD + 16 + 31) / 32;
    static constexpr int NKT = 2 * NKS;
    static constexpr int NKL = 112 + NKT * 16;
    static constexpr int KST = 72, VST = 72;
    static constexpr int NP = (NKL * 8 + NTHREADS - 1) / NTHREADS;
};
template <int RAD, bool ISB>
__device__ __forceinline__ void attn_load(const Ctx& X, const AttnDesc& d, int tid, u32x4 (&kr)[AttnGeo<RAD>::NP], u32x4 (&vr)[AttnGeo<RAD>::NP]) {
    using Gm = AttnGeo<RAD>; using P = AttnPtr<ISB>; const bf16_t* Kp = P::K(X, d); const bf16_t* Vp = P::V(X, d);
#pragma unroll
    for (int i = 0; i < Gm::NP; ++i) {
        const int p = tid + i * NTHREADS; const int jj = p >> 3, dc = p & 7; const int l = d.l0 - RAD + jj;
        kr[i] = (u32x4){0u, 0u, 0u, 0u}; vr[i] = (u32x4){0u, 0u, 0u, 0u};
        if (p < Gm::NKL * 8 && l >= 0 && l < d.L && jj < 128 + 2 * RAD) { const size_t row = (size_t)d.row_base + (size_t)l * d.dil; kr[i] = *(const u32x4*)(Kp + row * P::ldkv + dc * 8); vr[i] = *(const u32x4*)(Vp + row * P::ldkv + dc * 8); }
    }
}
template <int RAD>
__device__ __forceinline__ void attn_store(unsigned char* lds, int tid, const u32x4 (&kr)[AttnGeo<RAD>::NP], const u32x4 (&vr)[AttnGeo<RAD>::NP]) {
    using Gm = AttnGeo<RAD>;
    bf16_t* Ks = (bf16_t*)lds; bf16_t* Vs = Ks + Gm::NKL * Gm::KST;
#pragma unroll
    for (int i = 0; i < Gm::NP; ++i) {
        const int p = tid + i * NTHREADS; const int jj = p >> 3, dc = p & 7;
        if (p < Gm::NKL * 8) { *(u32x4*)(Ks + jj * Gm::KST + dc * 8) = kr[i]; *(u32x4*)(Vs + jj * Gm::VST + dc * 8) = vr[i]; }
    }
}
template <int RAD, bool SINK, bool ISB, bool TAB>
__device__ __forceinline__ void attn_head(const unsigned char* lds, const Ctx& X, const AttnDesc& d, int g, bf16x8 q0, bf16x8 q1, float sscale, const float* sinkp, int wid, int fr, int fq, const float (&arf)[AttnGeo<RAD>::NKT][4], bool edge) {
    using Gm = AttnGeo<RAD>; constexpr int NKT = Gm::NKT, NKS = Gm::NKS, KST = Gm::KST, VST = Gm::VST;
    const bf16_t* Ks = (const bf16_t*)lds; const bf16_t* Vs = Ks + Gm::NKL * KST;
    const int lq = d.l0 + 16 * wid + fr; const size_t qrow = (size_t)d.row_base + (size_t)lq * d.dil;
    using P = AttnPtr<ISB>;
    __builtin_amdgcn_sched_barrier(0);
    constexpr float L2E = 1.4426950408889634f;
    const float slope = exp2f(-sscale * (float)(P::head0(d) + g + 1)) * (float)d.dil * L2E;
    const float sinkv = SINK ? sinkp[P::head0(d) + g] * L2E : 0.f;
    f32x4 s[NKT];
#pragma unroll
    for (int kt = 0; kt < NKT; ++kt) {
        const bf16_t* kr = Ks + (16 * wid + 16 * kt + fr) * KST + 8 * fq;
        f32x4 c = (f32x4){0.f, 0.f, 0.f, 0.f};
        c = mma16(*(const bf16x8*)kr, q0, c); c = mma16(*(const bf16x8*)(kr + 32), q1, c);
        s[kt] = c;
        if (!ISB) __builtin_amdgcn_sched_barrier(0);
    }
    float mx = SINK ? sinkv : -1e30f;
    if (TAB && !edge) {
#pragma unroll
        for (int kt = 0; kt < NKT; ++kt)
#pragma unroll
            for (int r = 0; r < 4; ++r) { const float v = fmaf(s[kt][r], 0.125f * L2E, -slope * arf[kt][r]); s[kt][r] = v; mx = fmaxf(mx, v); }
    } else {
        int frm = fr, lqm = lq; asm volatile("" : "+v"(frm), "+v"(lqm));
#pragma unroll
        for (int kt = 0; kt < NKT; ++kt)
#pragma unroll
            for (int r = 0; r < 4; ++r) {
                const int jl = 16 * kt + 4 * fq + r; const int rel = jl - RAD - frm; const int lk = lqm + rel; const int ar = rel < 0 ? -rel : rel;
                const bool ok = (ar <= RAD) && (lk >= 0) && (lk < d.L);
                const float v = ok ? fmaf(s[kt][r], 0.125f * L2E, -slope * (float)ar) : -1e30f;
                s[kt][r] = v; mx = fmaxf(mx, v);
            }
    }
    mx = fmaxf(mx, __shfl_xor(mx, 16)); mx = fmaxf(mx, __shfl_xor(mx, 32));
    float den = 0.f;
#pragma unroll
    for (int kt = 0; kt < NKT; ++kt)
#pragma unroll
        for (int r = 0; r < 4; ++r) { const float p = __builtin_amdgcn_exp2f(s[kt][r] - mx); s[kt][r] = p; den += p; }
    den += __shfl_xor(den, 16); den += __shfl_xor(den, 32);
    if (SINK) den += __builtin_amdgcn_exp2f(sinkv - mx);
    f32x4 o[4];
#pragma unroll
    for (int db = 0; db < 4; ++db) o[db] = (f32x4){0.f, 0.f, 0.f, 0.f};
#pragma unroll
    for (int ks = 0; ks < NKS; ++ks) {
        u32x4 pw; pw.x = cvt_pk_bf16(s[2 * ks][0], s[2 * ks][1]); pw.y = cvt_pk_bf16(s[2 * ks][2], s[2 * ks][3]); pw.z = cvt_pk_bf16(s[2 * ks + 1][0], s[2 * ks + 1][1]); pw.w = cvt_pk_bf16(s[2 * ks + 1][2], s[2 * ks + 1][3]);
        const bf16x8 pf = __builtin_bit_cast(bf16x8, pw);
#pragma unroll
        for (int db = 0; db < 4; ++db) {
            const bf16_t* vr = Vs + (16 * wid + 32 * ks + 4 * fq + (fr >> 2)) * VST + 16 * db + 4 * (fr & 3);
            const u32x2 lo = tr_read(vr), hi = tr_read(vr + 16 * VST);
            const u32x4 aw = (u32x4){lo.x, lo.y, hi.x, hi.y};
            o[db] = mma16(__builtin_bit_cast(bf16x8, aw), pf, o[db]);
        }
        if (!ISB) __builtin_amdgcn_sched_barrier(0);
    }
    const float inv = 1.f / den;
#pragma unroll
    for (int db = 0; db < 4; ++db) { u32x2 w; w.x = cvt_pk_bf16(o[db][0] * inv, o[db][1] * inv); w.y = cvt_pk_bf16(o[db][2] * inv, o[db][3] * inv);
        *(u32x2*)(P::O(X, d) + qrow * P::ldo + g * 64 + 16 * db + 4 * fq) = w; }
    if (ISB && fq == 0) P::LSE(X, d)[qrow * 8] = (mx + __log2f(den)) * 0.6931471805599453f;
}
__device__ __forceinline__ void decode_b(int uu, AttnDesc& d) {
    const int di = uu >> 10; int r = uu & 1023; const int h = r & 7; r >>= 3;
    const int dl = di == 0 ? 1 : (di == 1 ? 4 : 16); const int nqb = 64 / dl; const int n = r / nqb, qb = r - n * nqb;
    const int batch = n / dl, res = n - batch * dl;
    d.row_base = batch * SEQ + res; d.dil = dl; d.L = SEQ / dl; d.l0 = qb * 128; d.hsel = h; d.di = di;
}
__device__ __forceinline__ void decode_c(int uu, AttnDesc& d) {
    const int qb = uu & 63, kvh = (uu >> 6) & 3, batch = uu >> 8;
    d.row_base = batch * SEQ; d.dil = 1; d.L = SEQ; d.l0 = qb * 128; d.hsel = kvh; d.di = 0;
}
template <int RAD, int G, bool SINK, bool ISB>
__device__ __forceinline__ void phase_attn(unsigned char* lds, const Ctx& X, int nunits, float sscale, const float* sinkp) {
    using Gm = AttnGeo<RAD>; constexpr bool TAB = ISB;
    const int tid = tid_l(), lane = tid & 63, wid = tid >> 6, fr = lane & 15, fq = lane >> 4;
    float arf[Gm::NKT][4];
#pragma unroll
    for (int kt = 0; kt < Gm::NKT; ++kt)
#pragma unroll
        for (int r = 0; r < 4; ++r) { const int rel = 16 * kt + 4 * fq + r - RAD - fr; const int ar = rel < 0 ? -rel : rel; arf[kt][r] = TAB ? ((ar <= RAD) ? (float)ar : 1e30f) : 0.f; }
    u32x4 kr[Gm::NP], vr[Gm::NP];
    AttnDesc d, dn;
    int uu = X.bid;
    bf16x8 qa0 = {0, 0, 0, 0, 0, 0, 0, 0}, qa1 = qa0;
    if (uu < nunits) {
        if (ISB) decode_b(uu, d); else decode_c(uu, d); attn_load<RAD, ISB>(X, d, tid, kr, vr);
        const size_t qrow = (size_t)d.row_base + (size_t)(d.l0 + 16 * wid + fr) * d.dil; const bf16_t* qp = AttnPtr<ISB>::Q(X, d) + qrow * AttnPtr<ISB>::ldq + 8 * fq;
        qa0 = *(const bf16x8*)qp; qa1 = *(const bf16x8*)(qp + 32);
    }
    for (; uu < nunits; uu += X.G) {
        attn_store<RAD>(lds, tid, kr, vr);
        __syncthreads();
        const bf16_t* qptr; { const size_t qrow = (size_t)d.row_base + (size_t)(d.l0 + 16 * wid + fr) * d.dil; qptr = AttnPtr<ISB>::Q(X, d) + qrow * AttnPtr<ISB>::ldq + 8 * fq; }
        const bool edge = (d.l0 - RAD < 0) || (d.l0 + 128 + RAD > d.L);
        if (!ISB) { qa0 = *(const bf16x8*)qptr; qa1 = *(const bf16x8*)(qptr + 32); }
        const int nx = uu + X.G; bf16x8 qb0 = qa0, qb1 = qa1;
        dn = d; if (nx < nunits) { if (ISB) decode_b(nx, dn); else decode_c(nx, dn); attn_load<RAD, ISB>(X, dn, tid, kr, vr);
            const size_t qrow = (size_t)dn.row_base + (size_t)(dn.l0 + 16 * wid + fr) * dn.dil; const bf16_t* qp = AttnPtr<ISB>::Q(X, dn) + qrow * AttnPtr<ISB>::ldq + 8 * fq;
            if (ISB) { qb0 = *(const bf16x8*)qp; qb1 = *(const bf16x8*)(qp + 32); } }
#pragma unroll 1
        for (int g = 0; g < G; ++g) {
            bf16x8 qn0 = qa0, qn1 = qa1;
            if (g + 1 < G) { qn0 = *(const bf16x8*)(qptr + (g + 1) * 64); qn1 = *(const bf16x8*)(qptr + (g + 1) * 64 + 32); }
            attn_head<RAD, SINK, ISB, TAB>(lds, X, d, g, qa0, qa1, sscale, sinkp, wid, fr, fq, arf, edge);
            qa0 = qn0; qa1 = qn1;
        }
        __syncthreads();
        d = dn; if (ISB) { qa0 = qb0; qa1 = qb1; }
    }
}
__device__ __forceinline__ void phase_merge_b(const Ctx& X) {
    const int nitems = T * 64;
    for (int idx = X.bid * NTHREADS + tid_l(); idx < nitems; idx += X.G * NTHREADS) {
        const int t = idx >> 6, h = (idx >> 3) & 7, dc = idx & 7;
        const float l0 = X_lse[(size_t)t * 8 + h], l1 = X_lse[(size_t)(T + t) * 8 + h], l2 = X_lse[(size_t)(2 * T + t) * 8 + h];
        const float m = fmaxf(l0, fmaxf(l1, l2)); float w0 = __expf(l0 - m), w1 = __expf(l1 - m), w2 = __expf(l2 - m); const float inv = 1.f / (w0 + w1 + w2); w0 *= inv; w1 *= inv; w2 *= inv;
        const size_t off = (size_t)t * 512 + h * 64 + dc * 8;
        const u32x4 a = *(const u32x4*)(X_ob + off), b = *(const u32x4*)(X_ob + (size_t)T * 512 + off), c = *(const u32x4*)(X_ob + (size_t)2 * T * 512 + off);
        u32x4 o;
        o.x = cvt_pk_bf16(w0 * bflo(a.x) + w1 * bflo(b.x) + w2 * bflo(c.x), w0 * bfhi(a.x) + w1 * bfhi(b.x) + w2 * bfhi(c.x));
        o.y = cvt_pk_bf16(w0 * bflo(a.y) + w1 * bflo(b.y) + w2 * bflo(c.y), w0 * bfhi(a.y) + w1 * bfhi(b.y) + w2 * bfhi(c.y));
        o.z = cvt_pk_bf16(w0 * bflo(a.z) + w1 * bflo(b.z) + w2 * bflo(c.z), w0 * bfhi(a.z) + w1 * bfhi(b.z) + w2 * bfhi(c.z));
        o.w = cvt_pk_bf16(w0 * bflo(a.w) + w1 * bflo(b.w) + w2 * bflo(c.w), w0 * bfhi(a.w) + w1 * bfhi(b.w) + w2 * bfhi(c.w));
        *(u32x4*)(X_mix + (size_t)t * 1024 + 512 + h * 64 + dc * 8) = o;
    }
}

__device__ __forceinline__ float logsigmoid_f(float g) { return fminf(g, 0.f) - log1pf(__expf(-fabsf(g))); }
__device__ __forceinline__ void phase_m1(unsigned char* lds, const Ctx& X, int j) {
    bf16_t* kS = (bf16_t*)lds; bf16_t* vS0 = kS + 64 * 144; bf16_t* vS1 = vS0 + 64 * 144; float* wa = (float*)(vS1 + 64 * 144);
    const int tid = tid_l(), lane = tid & 63, wid = tid >> 6, fr = lane & 15, fq = lane >> 4;
    const float* gb = X_ab_gate_b + j * 16;
    for (int uu = X.bid; uu < 1024; uu += X.G) {
        const int tc = uu & 127, h = (uu >> 7) & 3, b = uu >> 9; const int rowbase = b * SEQ + tc * 64; const int st0 = (b * 4 + h) * 2;
        if (wid < 2) {
            const int dd = wid; const int tok = dd ? 63 - lane : lane; const size_t row = (size_t)rowbase + tok;
            const int stream = st0 + dd, c = dd ? 127 - tc : tc;
            const float gi = X_gates[row * 16 + dd * 4 + h] + gb[dd * 4 + h];
            const float gf = X_gates[row * 16 + 8 + dd * 4 + h] + gb[8 + dd * 4 + h];
            const float bcum = incl_sum(logsigmoid_f(gf), lane); const float u = gi - bcum; const float pm = incl_max(u, lane);
            const float pm63 = __shfl(pm, 63), bl = __shfl(bcum, 63);
            wa[dd * 64 + tok] = __expf(u - pm63);
            if (lane == 0) { X_mc[stream * 128 + c] = bl + pm63; X_bc[stream * 128 + c] = bl; }
        }
        u32x4 kv[2], vv[2];
#pragma unroll
        for (int i = 0; i < 2; ++i) { const int p = tid + i * NTHREADS; const int jj = p >> 4, ec = p & 15; const size_t row = (size_t)rowbase + jj;
            kv[i] = *(const u32x4*)(X_kc + row * 512 + h * 128 + ec * 8); vv[i] = *(const u32x4*)(X_big + row * AB_LD + PC_V + h * 128 + ec * 8); }
        __syncthreads();
#pragma unroll
        for (int i = 0; i < 2; ++i) { const int p = tid + i * NTHREADS; const int jj = p >> 4, ec = p & 15;
            *(u32x4*)(kS + jj * 144 + ec * 8) = kv[i];
            const float w0 = wa[jj], w1 = wa[64 + jj]; const u32x4 v = vv[i];
            u32x4 a; a.x = cvt_pk_bf16(bflo(v.x) * w0, bfhi(v.x) * w0); a.y = cvt_pk_bf16(bflo(v.y) * w0, bfhi(v.y) * w0); a.z = cvt_pk_bf16(bflo(v.z) * w0, bfhi(v.z) * w0); a.w = cvt_pk_bf16(bflo(v.w) * w0, bfhi(v.w) * w0);
            u32x4 c; c.x = cvt_pk_bf16(bflo(v.x) * w1, bfhi(v.x) * w1); c.y = cvt_pk_bf16(bflo(v.y) * w1, bfhi(v.y) * w1); c.z = cvt_pk_bf16(bflo(v.z) * w1, bfhi(v.z) * w1); c.w = cvt_pk_bf16(bflo(v.w) * w1, bfhi(v.w) * w1);
            *(u32x4*)(vS0 + jj * 144 + ec * 8) = a; *(u32x4*)(vS1 + jj * 144 + ec * 8) = c; }
        __syncthreads();
        {
            const int trrow = 4 * fq + (fr >> 2), trcol = 4 * (fr & 3);
            bf16x8 bf0[2], bf1[2];
#pragma unroll
            for (int ks = 0; ks < 2; ++ks) {
                const bf16_t* vp = vS0 + (32 * ks + trrow) * 144 + 16 * wid + trcol; const u32x2 lo = tr_read(vp), hi = tr_read(vp + 16 * 144); bf0[ks] = __builtin_bit_cast(bf16x8, ((u32x4){lo.x, lo.y, hi.x, hi.y}));
                const bf16_t* vq = vS1 + (32 * ks + trrow) * 144 + 16 * wid + trcol; const u32x2 lo1 = tr_read(vq), hi1 = tr_read(vq + 16 * 144); bf1[ks] = __builtin_bit_cast(bf16x8, ((u32x4){lo1.x, lo1.y, hi1.x, hi1.y})); }
            bf16_t* cd0 = X_cst + (size_t)(st0 * 128 + tc) * 16384 + (size_t)(16 * wid + fr) * 128 + 4 * fq;
            bf16_t* cd1 = X_cst + (size_t)((st0 + 1) * 128 + (127 - tc)) * 16384 + (size_t)(16 * wid + fr) * 128 + 4 * fq;
#pragma unroll
            for (int eb = 0; eb < 8; ++eb) {
                f32x4 a0 = (f32x4){0.f, 0.f, 0.f, 0.f}, a1 = (f32x4){0.f, 0.f, 0.f, 0.f};
#pragma unroll
                for (int ks = 0; ks < 2; ++ks) { const bf16_t* kp = kS + (32 * ks + trrow) * 144 + 16 * eb + trcol; const u32x2 lo = tr_read(kp), hi = tr_read(kp + 16 * 144);
                    const bf16x8 kf = __builtin_bit_cast(bf16x8, ((u32x4){lo.x, lo.y, hi.x, hi.y}));
                    a0 = mma16(kf, bf0[ks], a0); a1 = mma16(kf, bf1[ks], a1); }
                u32x2 w; w.x = cvt_pk_bf16(a0[0], a0[1]); w.y = cvt_pk_bf16(a0[2], a0[3]); *(u32x2*)(cd0 + 16 * eb) = w;
                u32x2 y; y.x = cvt_pk_bf16(a1[0], a1[1]); y.y = cvt_pk_bf16(a1[2], a1[3]); *(u32x2*)(cd1 + 16 * eb) = y;
            }
            const int e = tid >> 2, dd = (tid >> 1) & 1, hf = tid & 1; float sm = 0.f;
#pragma unroll
            for (int i = 0; i < 32; ++i) sm += bf2f(kS[(32 * hf + i) * 144 + e]) * wa[dd * 64 + 32 * hf + i];
            sm += __shfl_xor(sm, 1);
            if (hf == 0) X_nst[(size_t)((st0 + dd) * 128 + (dd ? 127 - tc : tc)) * 128 + e] = sm;
        }
        __syncthreads();
    }
}
template <bool DRY>
__device__ __forceinline__ void phase_m2(unsigned char* lds, const Ctx& X) {
    float* mcL = (float*)lds; float* bcL = mcL + 128; float* soL = bcL + 128; float* snL = soL + 128; float* mpL = snL + 128;
    const int tid = tid_l();
    for (int wi = X.bid; wi < 256; wi += X.G) {
        const int stream = wi >> 4, sl = wi & 15;
        if (tid < 128) { mcL[tid] = X_mc[stream * 128 + tid]; bcL[tid] = X_bc[stream * 128 + tid]; }
        __syncthreads();
        if (tid == 0) {
            float m = 0.f;
#pragma unroll 4
            for (int c = 0; c < 128; ++c) { const float mcv = mcL[c], bcv = bcL[c]; mpL[c] = m; const float mn = fmaxf(bcv + m, mcv); soL[c] = __expf(bcv + m - mn); snL[c] = __expf(mcv - mn); m = mn; }
        }
        __syncthreads();
        if (!DRY && sl == 0 && tid < 128) X_mprev[stream * 128 + tid] = mpL[tid];
        {
            unsigned* p = (unsigned*)(X_cst + (size_t)stream * 128 * 16384) + sl * 512 + tid;
            float c0 = 0.f, c1 = 0.f;
#pragma unroll 1
            for (int cb = 0; cb < 128; cb += 16) {
                unsigned v[16];
#pragma unroll
                for (int i = 0; i < 16; ++i) v[i] = p[(size_t)(cb + i) * 8192];
#pragma unroll
                for (int i = 0; i < 16; ++i) {
                    if (!DRY || c0 == 12345.678f) p[(size_t)(cb + i) * 8192] = cvt_pk_bf16(c0, c1);
                    const float so = soL[cb + i], sn = snL[cb + i];
                    c0 = so * c0 + sn * bflo(v[i]); c1 = so * c1 + sn * bfhi(v[i]);
                }
            }
        }
        if (sl == 0 && tid < 128) {
            float* p = X_nst + (size_t)stream * 128 * 128 + tid; float n0 = 0.f;
#pragma unroll 1
            for (int cb = 0; cb < 128; cb += 16) {
                float v[16];
#pragma unroll
                for (int i = 0; i < 16; ++i) v[i] = p[(cb + i) * 128];
#pragma unroll
                for (int i = 0; i < 16; ++i) { if (!DRY || n0 == 12345.678f) p[(cb + i) * 128] = n0; n0 = soL[cb + i] * n0 + snL[cb + i] * v[i]; }
            }
        }
        __syncthreads();
    }
}
__device__ __forceinline__ void phase_m3(unsigned char* lds, const Ctx& X, int j) {
    bf16_t* qL = (bf16_t*)lds;
    bf16_t* kL = qL + 64 * 136;
    bf16_t* vS = kL + 64 * 136;
    float* hbuf = (float*)(vS + 64 * 144);
    float* gt = hbuf + 64 * 132;
    float* nP = gt + 512;
    const int tid = tid_l(), lane = tid & 63, wid = tid >> 6, fr = lane & 15, fq = lane >> 4;
    const float* gb = X_ab_gate_b + j * 16; const float* hg = X_ab_hnorm_g + j * 512;
    for (int uu = X.bid; uu < 1024; uu += X.G) {
        int uv = uu; asm volatile("" : "+v"(uv));
        const int tc = uv & 127, h = (uv >> 7) & 3, b = uv >> 9; const int rowbase = b * SEQ + tc * 64;
        const int st0 = (b * 4 + h) * 2;
        bf16x8 cf[4][4];
        { const bf16_t* cbase = X_cst + (size_t)(st0 * 128 + tc) * 16384 + (size_t)(64 * (wid & 1) + fr) * 128 + 8 * fq;
#pragma unroll
          for (int dbi = 0; dbi < 4; ++dbi)
#pragma unroll
              for (int ks = 0; ks < 4; ++ks) cf[dbi][ks] = *(const bf16x8*)(cbase + (size_t)dbi * 16 * 128 + 32 * ks); }
        if (wid < 2) {
            const int dd = wid; const int tok = dd ? 63 - lane : lane; const size_t row = (size_t)rowbase + tok;
            const int stream = st0 + dd, c = dd ? 127 - tc : tc;
            const float gi = X_gates[row * 16 + dd * 4 + h] + gb[dd * 4 + h];
            const float gf = X_gates[row * 16 + 8 + dd * 4 + h] + gb[8 + dd * 4 + h];
            const float bcum = incl_sum(logsigmoid_f(gf), lane); const float u = gi - bcum; const float pm = incl_max(u, lane);
            const float mp = X_mprev[stream * 128 + c]; const float M = fmaxf(mp, pm);
            float* g4 = gt + 256 * dd;
            g4[tok] = u; g4[64 + tok] = M; g4[128 + tok] = __expf(mp - M); g4[192 + tok] = __expf(-(bcum + M));
        } else if (wid < 4) {
            const int dd = wid - 2; const int stream = st0 + dd, c = dd ? 127 - tc : tc;
            nP[dd * 128 + lane] = X_nst[(size_t)(stream * 128 + c) * 128 + lane]; nP[dd * 128 + lane + 64] = X_nst[(size_t)(stream * 128 + c) * 128 + lane + 64];
        }
        for (int p = tid; p < 1024; p += NTHREADS) {
            const int jj = p >> 4, ec = p & 15; const size_t row = (size_t)rowbase + jj;
            *(u32x4*)(qL + jj * 136 + ec * 8) = *(const u32x4*)(X_qc + row * 512 + h * 128 + ec * 8);
            *(u32x4*)(kL + jj * 136 + ec * 8) = *(const u32x4*)(X_kc + row * 512 + h * 128 + ec * 8);
            *(u32x4*)(vS + jj * 144 + ec * 8) = *(const u32x4*)(X_big + row * AB_LD + PC_V + h * 128 + ec * 8);
        }
        const int ntok = tid >> 3, npart = tid & 7; const size_t nrow = (size_t)rowbase + ntok; const int ncol = h * 128 + npart * 16;
        const u32x4 o0 = *(const u32x4*)(X_big + nrow * AB_LD + PC_O + ncol), o1 = *(const u32x4*)(X_big + nrow * AB_LD + PC_O + ncol + 8);
        __syncthreads();
        {
            const int tb = wid >> 1, dh = wid & 1; const int t = 16 * tb + fr;
            bf16x8 qf[4];
#pragma unroll
            for (int ks = 0; ks < 4; ++ks) qf[ks] = *(const bf16x8*)(qL + t * 136 + 32 * ks + 8 * fq);
            const float M0 = gt[64 + t], si0 = gt[128 + t], em0 = gt[192 + t], M1 = gt[256 + 64 + t], si1 = gt[256 + 128 + t], em1 = gt[256 + 192 + t];
            float qn0 = 0.f, qn1 = 0.f;
#pragma unroll
            for (int ks = 0; ks < 4; ++ks)
#pragma unroll
                for (int i = 0; i < 8; ++i) { const float qv = bf2f((unsigned short)qf[ks][i]); qn0 += qv * nP[32 * ks + 8 * fq + i]; qn1 += qv * nP[128 + 32 * ks + 8 * fq + i]; }
            qn0 += __shfl_xor(qn0, 16); qn0 += __shfl_xor(qn0, 32); qn1 += __shfl_xor(qn1, 16); qn1 += __shfl_xor(qn1, 32);
            f32x4 sw0[4], sw1[4]; float ds0 = 0.f, ds1 = 0.f;
#pragma unroll
            for (int sb = 0; sb < 4; ++sb) {
                f32x4 a = (f32x4){0.f, 0.f, 0.f, 0.f};
                const bf16_t* kr = kL + (16 * sb + fr) * 136 + 8 * fq;
#pragma unroll
                for (int ks = 0; ks < 4; ++ks) a = mma16(*(const bf16x8*)(kr + 32 * ks), qf[ks], a);
#pragma unroll
                for (int r = 0; r < 4; ++r) { const int s = 16 * sb + 4 * fq + r;
                    const float w0 = (s <= t) ? __expf(gt[s] - M0) * a[r] : 0.f, w1 = (s >= t) ? __expf(gt[256 + s] - M1) * a[r] : 0.f;
                    sw0[sb][r] = w0; sw1[sb][r] = w1; ds0 += w0; ds1 += w1; }
            }
            ds0 += __shfl_xor(ds0, 16); ds0 += __shfl_xor(ds0, 32); ds1 += __shfl_xor(ds1, 16); ds1 += __shfl_xor(ds1, 32);
            const float inv0 = 1.f / fmaxf(fabsf(ds0 + si0 * qn0), em0), inv1 = 1.f / fmaxf(fabsf(ds1 + si1 * qn1), em1);
            bf16x8 wf0[2], wf1[2];
#pragma unroll
            for (int ss2 = 0; ss2 < 2; ++ss2) {
                u32x4 pw; pw.x = cvt_pk_bf16(sw0[2 * ss2][0], sw0[2 * ss2][1]); pw.y = cvt_pk_bf16(sw0[2 * ss2][2], sw0[2 * ss2][3]); pw.z = cvt_pk_bf16(sw0[2 * ss2 + 1][0], sw0[2 * ss2 + 1][1]); pw.w = cvt_pk_bf16(sw0[2 * ss2 + 1][2], sw0[2 * ss2 + 1][3]); wf0[ss2] = __builtin_bit_cast(bf16x8, pw);
                u32x4 pv; pv.x = cvt_pk_bf16(sw1[2 * ss2][0], sw1[2 * ss2][1]); pv.y = cvt_pk_bf16(sw1[2 * ss2][2], sw1[2 * ss2][3]); pv.z = cvt_pk_bf16(sw1[2 * ss2 + 1][0], sw1[2 * ss2 + 1][1]); pv.w = cvt_pk_bf16(sw1[2 * ss2 + 1][2], sw1[2 * ss2 + 1][3]); wf1[ss2] = __builtin_bit_cast(bf16x8, pv);
            }
            f32x4 h0[4], b1[4];
#pragma unroll
            for (int dbi = 0; dbi < 4; ++dbi) {
                const int db = 4 * dh + dbi;
                f32x4 a10 = (f32x4){0.f, 0.f, 0.f, 0.f}, a11 = (f32x4){0.f, 0.f, 0.f, 0.f}, a2 = (f32x4){0.f, 0.f, 0.f, 0.f};
#pragma unroll
                for (int ss2 = 0; ss2 < 2; ++ss2) {
                    const bf16_t* vr = vS + (32 * ss2 + 4 * fq + (fr >> 2)) * 144 + 16 * db + 4 * (fr & 3);
                    const u32x2 lo = tr_read(vr), hi = tr_read(vr + 16 * 144);
                    const bf16x8 vf = __builtin_bit_cast(bf16x8, ((u32x4){lo.x, lo.y, hi.x, hi.y}));
                    a10 = mma16(vf, wf0[ss2], a10); a11 = mma16(vf, wf1[ss2], a11);
                }
#pragma unroll
                for (int ks = 0; ks < 4; ++ks) a2 = mma16(cf[dbi][ks], qf[ks], a2);
                h0[dbi] = (a10 + a2 * si0) * inv0; b1[dbi] = a11;
            }
            { const bf16_t* cbase = X_cst + (size_t)((st0 + 1) * 128 + (127 - tc)) * 16384 + (size_t)(64 * dh + fr) * 128 + 8 * fq;
#pragma unroll
              for (int dbi = 0; dbi < 4; ++dbi)
#pragma unroll
                  for (int ks = 0; ks < 4; ++ks) cf[dbi][ks] = *(const bf16x8*)(cbase + (size_t)dbi * 16 * 128 + 32 * ks); }
#pragma unroll
            for (int dbi = 0; dbi < 4; ++dbi) {
                const int db = 4 * dh + dbi;
                f32x4 a2 = (f32x4){0.f, 0.f, 0.f, 0.f};
#pragma unroll
                for (int ks = 0; ks < 4; ++ks) a2 = mma16(cf[dbi][ks], qf[ks], a2);
                const f32x4 hv = h0[dbi] + (b1[dbi] + a2 * si1) * inv1;
                *(f32x4*)(hbuf + t * 132 + 16 * db + 4 * fq) = hv;
            }
        }
        __syncthreads();
        {
            const float* hp = hbuf + ntok * 132 + npart * 16; float v[16]; float sq = 0.f;
#pragma unroll
            for (int i = 0; i < 16; ++i) { v[i] = hp[i]; sq += v[i] * v[i]; }
            sq += __shfl_xor(sq, 1); sq += __shfl_xor(sq, 2); sq += __shfl_xor(sq, 4);
            const float r = rsqrtf(sq * (1.f / 128.f) + EPS);
            const unsigned ow[8] = {o0.x, o0.y, o0.z, o0.w, o1.x, o1.y, o1.z, o1.w};
            unsigned res[8];
#pragma unroll
            for (int i = 0; i < 8; ++i) {
                const float y0 = v[2 * i] * r * hg[ncol + 2 * i] * sigmoid_f(bflo(ow[i])), y1 = v[2 * i + 1] * r * hg[ncol + 2 * i + 1] * sigmoid_f(bfhi(ow[i]));
                res[i] = cvt_pk_bf16(y0, y1);
            }
            *(u32x4*)(X_mix + nrow * 1024 + ncol) = (u32x4){res[0], res[1], res[2], res[3]};
            *(u32x4*)(X_mix + nrow * 1024 + ncol + 8) = (u32x4){res[4], res[5], res[6], res[7]};
        }
        __syncthreads();
    }
}


#define XB_TMO      128
#define XB_XCNT(j)  (256  + 64 * (j))
#define XB_XSUB(j)  (1280 + 64 * (j))
#define XB_XGEN(j)  (2304 + 64 * (j))
#define XB_TOP      3328
#define XB_TOPGEN   3392
#define XCD_BAR_WORDS 3456
#define XB_SPIN_CAP (1u << 18)
__device__ __forceinline__ unsigned xb_ld(unsigned* p)              { return __hip_atomic_load(p, __ATOMIC_RELAXED, __HIP_MEMORY_SCOPE_AGENT); }
__device__ __forceinline__ unsigned xb_add(unsigned* p, unsigned v) { return __hip_atomic_fetch_add(p, v, __ATOMIC_RELAXED, __HIP_MEMORY_SCOPE_AGENT); }
__device__ __forceinline__ unsigned xb_xcc_id() { return (unsigned)__builtin_amdgcn_s_getreg((3 << 11) | 20) & 0xFu; }
#define XB_SPIN(cond, bar) do { unsigned _sp = 0; while (cond) { __builtin_amdgcn_s_sleep(1); \
    if ((++_sp & 255u) == 0u) { if (xb_ld(&(bar)[XB_TMO])) break; if (_sp > XB_SPIN_CAP) { atomicAdd(&(bar)[XB_TMO], 1u); break; } } } } while (0)
struct XcdBarrier { unsigned* bar; unsigned x; volatile LAS unsigned* st; };
__device__ __forceinline__ XcdBarrier xcd_barrier_post(unsigned* bar, volatile LAS unsigned* st) {
    XcdBarrier b; b.bar = bar; b.x = xb_xcc_id(); b.st = st;
    if (threadIdx.x == 0) (void)xb_add(&bar[XB_XCNT(b.x)], 1u);
    return b;
}
__device__ __forceinline__ void xcd_barrier_complete(unsigned* bar, unsigned x, unsigned& nloc, unsigned& nx) {
    const unsigned G = gridDim.x * gridDim.y * gridDim.z;
    unsigned sum, cnt, mine, sp = 0u;
    for (;;) {
        sum = 0u; cnt = 0u; mine = 0u;
#pragma unroll
        for (unsigned j = 0; j < 16; ++j) { const unsigned c = xb_ld(&bar[XB_XCNT(j)]); sum += c; cnt += (c > 0u) ? 1u : 0u; mine = (j == x) ? c : mine; }
        if (sum == G) break;
        __builtin_amdgcn_s_sleep(1);
        if ((++sp & 255u) == 0u) { if (xb_ld(&bar[XB_TMO])) break; if (sp > XB_SPIN_CAP) { atomicAdd(&bar[XB_TMO], 1u); break; } }
    }
    nloc = mine > 0u ? mine : 1u; nx = cnt > 0u ? cnt : 1u;
}
__device__ __forceinline__ void xcd_barrier(const XcdBarrier& b) {
    asm volatile("s_waitcnt vmcnt(0)" ::: "memory");
    __syncthreads();
    if (threadIdx.x == 0) {
        unsigned* bar = b.bar;
        __builtin_amdgcn_s_waitcnt(0);
        unsigned nloc = b.st[0], nx = b.st[1];
        if (nloc == 0u) { xcd_barrier_complete(bar, b.x, nloc, nx); b.st[0] = nloc; b.st[1] = nx; }
        const unsigned old = xb_add(&bar[XB_XSUB(b.x)], 1u);
        const unsigned gen = old / nloc;
        if (old + 1u == (gen + 1u) * nloc) {
            __builtin_amdgcn_fence(__ATOMIC_RELEASE, "agent");
            asm volatile("s_waitcnt vmcnt(0)" ::: "memory");
            const unsigned og = xb_add(&bar[XB_TOP], 1u);
            const unsigned tg = og / nx;
            if (og + 1u == (tg + 1u) * nx) xb_add(&bar[XB_TOPGEN], 1u);
            else XB_SPIN(xb_ld(&bar[XB_TOPGEN]) == tg, bar);
            __builtin_amdgcn_fence(__ATOMIC_ACQUIRE, "agent");
            xb_add(&bar[XB_XGEN(b.x)], 1u);
            asm volatile("s_waitcnt vmcnt(0)" ::: "memory");
        } else {
            XB_SPIN(xb_ld(&bar[XB_XGEN(b.x)]) == gen, bar);
            __builtin_amdgcn_fence(__ATOMIC_ACQUIRE, "agent");
            asm volatile("s_waitcnt vmcnt(0)" ::: "memory");
        }
    }
    __syncthreads();
}
constexpr size_t WS_BAR = WS_END + 4096;
constexpr int LDS_MISC = LDS_BYTES - 64;
#ifdef DEBUG_CHK
constexpr size_t WS_CODE = WS_END + 256;
__global__ void chk_kernel(const void* p, size_t n16, int is_bf16, unsigned* code, unsigned val, float lim) {
    const u32x4* v = (const u32x4*)p; bool bad = false;
    for (size_t i = (size_t)blockIdx.x * blockDim.x + threadIdx.x; i < n16; i += (size_t)gridDim.x * blockDim.x) {
        const u32x4 w = v[i]; const unsigned a[4] = {w.x, w.y, w.z, w.w};
#pragma unroll
        for (int q = 0; q < 4; ++q) {
            if (is_bf16) { const float lo = bflo(a[q]), hi = bfhi(a[q]); if (!(fabsf(lo) < lim) || !(fabsf(hi) < lim)) bad = true; }
            else { const float f = __builtin_bit_cast(float, a[q]); if (!(fabsf(f) < lim)) bad = true; }
        }
    }
    if (bad) atomicMin(code, val);
}
#endif
constexpr int PH_PER_LAYER = 11, PH_FINAL = 1 + 4 * PH_PER_LAYER, N_PHASES = PH_FINAL + 1;
__host__ __device__ inline bool phase_is_noop(int p) { if (p < 1 || p >= PH_FINAL) return false; const int q = p - 1, l = q / PH_PER_LAYER, k = q % PH_PER_LAYER; return ((l & 1) && (k >= 5 && k <= 7)) || (k == 0 && l > 0); }

__global__ void __launch_bounds__(NTHREADS, 2) fwd_kernel(Args args) {
    extern __shared__ __attribute__((aligned(16))) unsigned char lds[];
    volatile LAS unsigned* xst = (volatile LAS unsigned*)((LAS unsigned char*)lds + LDS_MISC);
    if (threadIdx.x < 2) xst[threadIdx.x] = 0u;
    __syncthreads();
    XcdBarrier xbar; xbar.bar = (unsigned*)(args.ws + WS_BAR); xbar.x = 0; xbar.st = xst;
    if (!MK_PER_PHASE) xbar = xcd_barrier_post((unsigned*)(args.ws + WS_BAR), xst);
    if (args.ph_lo == 0) {
        if (blockIdx.x == 0 && threadIdx.x < 16) {
            const float** tab = (const float**)(args.ws + WS_TAB);
            const int i = threadIdx.x;
            const float* v = args.out;
#pragma unroll
            for (int k = 0; k < 15; ++k) if (i == k) v = args.in[k];
            tab[i] = v;
        }
        if (args.ph_hi < 0) cg::this_grid().sync();
        if (args.ph_hi > 1) xcd_barrier(xbar);
    }
    const int p_lo = args.ph_lo < 1 ? 1 : args.ph_lo, p_hi = args.ph_hi;
    unsigned char* ws0 = args.ws;
    const int G0 = gridDim.x, bid0 = blockIdx.x;
    for (int pp = 2 * p_lo; pp < 2 * p_hi; ++pp) {
        const int p = pp >> 1;
        if (phase_is_noop(p)) continue;
        const bool dupable = DUPMASK != 0 && p != PH_FINAL && ((DUPMASK >> ((p - 1) % PH_PER_LAYER)) & 1);
        if ((pp & 1) && !dupable) continue;
        Ctx X; X.G = G0; X.bid = bid0;
        { size_t z = 0; asm volatile("" : "+s"(z)); X.ws = ws0 + z; }
        LAS unsigned char* ldsl = (LAS unsigned char*)lds;
        if (p == PH_FINAL) {
#ifdef DEBUG_CHK
            const unsigned code = *(const unsigned*)(X.ws + WS_CODE);
            if (code < 1000u) {
                const float a = sqrtf(0.2f * (float)code);
                for (size_t i = (size_t)X.bid * NTHREADS + threadIdx.x; i < (size_t)T * D; i += (size_t)X.G * NTHREADS) X_out[i] = (i & 1) ? a : -a;
            } else
#endif
            if (PHON(11)) phase_final(X); }
        else {
            const int q = p - 1, l = q / PH_PER_LAYER, k = q - l * PH_PER_LAYER, j = l >> 1; const bool even = (l & 1) == 0;
            if (k == 0) { if (PHON(0)) { phase_convert(lds, X, 0, 3, X.bid, X.G); phase_init(X); } }
            else if (PHON(1) && (k == 1 || k == 9)) {
                pg8::Gemm g{X_xb, k == 1 ? X_Wup1 : X_Wup2, T, NUP, D}; pg8::StaticOrder S; S.init(T, NUP, X.G, X.bid);
                pg8::fill_rstd(ldsl, X_ss, S);
                pg8::EpiUp E{X_big, (LAS const float*)(ldsl + pg8::LDS_RTAB)};
                for (int r = 0; r < GEMM_REPS; ++r) { pg8::gemm_phase<pg8::EpiUp, pg8::StaticOrder, true, true>(ldsl, g, S, E); if (r + 1 < GEMM_REPS) __syncthreads(); }
                if ((k == 9 && l < 3) || (k == 1 && l > 0)) convert_in_tail(lds, X, k == 9 ? l + 1 : l, k == 9 ? 1 : 2, (T / 256) * (NUP / 256));
            } else if (PHON(2) && (k == 2 || k == 10)) {
                pg8::Gemm g{X_big, k == 2 ? X_Wdn1 : X_Wdn2, T, D, FF}; pg8::StaticOrder S; S.init(T, D, X.G, X.bid);
                GAS float* outp = (GAS float*)X_out;
                for (int r = 0; r < GEMM_REPS; ++r) { pg8::EpiRes E{(l == 0 && k == 2) ? (GAS const float*)X_x : (GAS const float*)outp, outp, X_xb, X_ss, (r + 1 < GEMM_REPS) ? 0.f : 0.5f};
                pg8::gemm_phase<pg8::EpiRes, pg8::StaticOrder, false, true>(ldsl, g, S, E); if (r + 1 < GEMM_REPS) __syncthreads(); }
            } else if (PHON(3) && k == 3) {
                const int N = even ? AB_N : C_N;
                pg8::Gemm g{X_xb, X_Win, T, N, D}; pg8::StaticOrder S; S.init(T, N, X.G, X.bid);
                pg8::fill_rstd(ldsl, X_ss, S);
                pg8::EpiProj E{X_big, even ? AB_LD : C_N, (LAS const float*)(ldsl + pg8::LDS_RTAB), X_gates, even ? 14 : -1};
                for (int r = 0; r < GEMM_REPS; ++r) { pg8::gemm_phase<pg8::EpiProj, pg8::StaticOrder, true, true>(ldsl, g, S, E); if (r + 1 < GEMM_REPS) __syncthreads(); }
            } else if (k == 4) {
                { if (even) { if (PHON(4)) { phase_attn<64, 1, false, true>(lds, X, 3072, 1.0f, nullptr); phase_conv(X, j); } } else { if (PHON(12)) phase_attn<128, 4, true, false>(lds, X, 512, 0.5f, X_c_sink + j * 16); } }
            } else if (PHON(5) && k == 5) { phase_m1(lds, X, j); }
            else if (PHON(6) && k == 6) { if (pp & 1) phase_m2<true>(lds, X); else phase_m2<false>(lds, X); }
            else if (PHON(7) && k == 7) { { phase_m3(lds, X, j); phase_merge_b(X); } }
            else if (PHON(8) && k == 8) {
                pg8::Gemm g{X_mix, X_Wout, T, D, D}; pg8::StaticOrder S; S.init(T, D, X.G, X.bid);
                GAS float* outp = (GAS float*)X_out;
                for (int r = 0; r < GEMM_REPS; ++r) { pg8::EpiRes E{(GAS const float*)outp, outp, X_xb, X_ss, (r + 1 < GEMM_REPS) ? 0.f : 1.0f};
                pg8::gemm_phase<pg8::EpiRes, pg8::StaticOrder, false, true>(ldsl, g, S, E); if (r + 1 < GEMM_REPS) __syncthreads(); }
            }
        }
        if (p + 1 < p_hi || (!(pp & 1) && dupable)) { for (int r = 0; r < SYNC_REPS; ++r) xcd_barrier(xbar); }
    }
}

extern "C" void kernel_launch(void* const* d_in, const int* in_sizes, int n_in, void* d_out, int out_size, void* d_ws, size_t ws_size, hipStream_t stream) {
    static int grid = 0;
    if (grid == 0) {
        int dev = 0, cus = 0, per_cu = 0;
        hipGetDevice(&dev);
        hipDeviceGetAttribute(&cus, hipDeviceAttributeMultiprocessorCount, dev);
        hipFuncSetAttribute((const void*)fwd_kernel, hipFuncAttributeMaxDynamicSharedMemorySize, LDS_BYTES);
        hipOccupancyMaxActiveBlocksPerMultiprocessor(&per_cu, (const void*)fwd_kernel, NTHREADS, LDS_BYTES);
        if (per_cu < 1) per_cu = 1;
        if (per_cu > 1) per_cu = 1;
        grid = cus * per_cu;
        if (ws_size < WS_END) fprintf(stderr, "kernel_launch: workspace too small (%zu < %zu)\n", ws_size, (size_t)WS_END);
        (void)hipGetLastError();
    }
    if (ws_size < WS_END + 32768) return;
    Args a{};
    for (int i = 0; i < 15; ++i) a.in[i] = (const float*)d_in[i];
    a.out = (float*)d_out; a.ws = (unsigned char*)d_ws;
#if MK_PER_PHASE
#ifdef DEBUG_CHK
    int seq = 0; hipMemsetAsync((unsigned char*)d_ws + WS_END + 256, 0x7F, 4, stream);
#endif
    for (int p = 0; p < N_PHASES; ++p) {
        if (phase_is_noop(p)) continue;
        a.ph_lo = p; a.ph_hi = p + 1;
        hipLaunchKernelGGL(fwd_kernel, dim3(grid), dim3(NTHREADS), LDS_BYTES, stream, a);
#ifdef DEBUG_CHK
        if (p >= 1 && p < PH_FINAL) {
            ++seq; const int q = p - 1, l = q / PH_PER_LAYER, k = q % PH_PER_LAYER; const bool even = (l & 1) == 0;
            unsigned char* w = (unsigned char*)d_ws; unsigned* code = (unsigned*)(w + WS_CODE);
#define CHK(ptr, bytes, isb) hipLaunchKernelGGL(chk_kernel, dim3(1024), dim3(256), 0, stream, (const void*)(ptr), (size_t)(bytes) / 16, isb, code, (unsigned)seq, lim)
            float lim = 300.f;
            if (k == 0) { CHK(w, 43 * MiB, 1); if (l == 0) { CHK(w + WS_XB, (size_t)T * D * 2, 1); lim = 1e5f; CHK(w + WS_SS, (size_t)T * 64, 0); } }
            else if (k == 1 || k == 9) { CHK(w + WS_BIG, (size_t)T * FF * 2, 1); }
            else if (k == 2 || k == 10 || k == 8) { CHK(d_out, (size_t)T * D * 4, 0); CHK(w + WS_XB, (size_t)T * D * 2, 1); lim = 1e5f; CHK(w + WS_SS, (size_t)T * 64, 0); }
            else if (k == 3) { CHK(w + WS_BIG, (size_t)T * (even ? AB_LD : C_N) * 2, 1); if (even) CHK(w + WS_GATES, (size_t)T * 64, 0); }
            else if (k == 4) { if (even) { CHK(w + WS_OB, (size_t)3 * T * 512 * 2, 1); CHK(w + WS_LSE, (size_t)3 * T * 32, 0); CHK(w + WS_XB, (size_t)T * D * 2, 1); } else CHK(w + WS_MIX, (size_t)T * D * 2, 1); }
            else if (k == 5) { lim = 3e3f; CHK(w + WS_CST, 64 * MiB, 1); CHK(w + WS_NST, 1 * MiB, 0); CHK(w + WS_MSC, 16384, 0); }
            else if (k == 6) { lim = 3e3f; CHK(w + WS_CST, 64 * MiB, 1); CHK(w + WS_NST, 1 * MiB, 0); CHK(w + WS_MSC, 24576, 0); }
            else if (k == 7) { CHK(w + WS_MIX, (size_t)T * D * 2, 1); }
        }
#endif
    }
#else
    a.ph_lo = 0; a.ph_hi = N_PHASES;
    hipMemsetAsync((unsigned char*)d_ws + WS_BAR, 0, 16384, stream);
    void* kargs[] = {&a};
    hipError_t e = hipLaunchCooperativeKernel((const void*)fwd_kernel, dim3(grid), dim3(NTHREADS), kargs, LDS_BYTES, stream);
    if (e != hipSuccess) fprintf(stderr, "cooperative launch failed: %s (grid %d)\n", hipGetErrorString(e), grid);
#endif
}
```

```cpp
#include <hip/hip_runtime.h>
#include <hip/hip_cooperative_groups.h>
#include <cstdio>
#include <cstdint>
namespace cg = cooperative_groups;

#ifndef MK_PER_PHASE
#define MK_PER_PHASE 0
#endif

#ifndef GEMM_REPS
#define GEMM_REPS 1
#endif
#ifndef DUPMASK
#define DUPMASK 0
#endif
#ifndef SYNC_REPS
#define SYNC_REPS 1
#endif
#ifndef PHMASK
#define PHMASK 0xffff
#endif
#define PHON(k) ((PHMASK >> (k)) & 1)
#define LAS __attribute__((address_space(3)))
#define GAS __attribute__((address_space(1)))
typedef unsigned short bf16_t;
typedef short bf16x8 __attribute__((ext_vector_type(8)));
typedef float f32x4 __attribute__((ext_vector_type(4)));
typedef float f32x2 __attribute__((ext_vector_type(2)));
typedef unsigned u32x4 __attribute__((ext_vector_type(4)));
typedef unsigned u32x2 __attribute__((ext_vector_type(2)));

constexpr int T = 16384, SEQ = 8192, D = 1024, FF = 2816, NUP = 2 * FF;
constexpr int AB_N = 3840, AB_LD = 3584, C_N = 1536;
constexpr int NTHREADS = 512;
constexpr float EPS = 1e-6f;
constexpr int PC_QK = 0, PC_V = 1024, PC_O = 1536, PC_QB = 2048, PC_KB = 2560, PC_VB = 3072;

constexpr size_t MiB = 1u << 20;
constexpr size_t W_UP_B = (size_t)NUP * D * 2, W_DN_B = (size_t)D * FF * 2, W_IN_B = (size_t)AB_N * D * 2, W_OUT_B = (size_t)D * D * 2;
constexpr size_t WS_WUP1 = 0, WS_WDN1 = WS_WUP1 + W_UP_B, WS_WUP2 = WS_WDN1 + W_DN_B, WS_WDN2 = WS_WUP2 + W_UP_B, WS_WIN = WS_WDN2 + W_DN_B, WS_WOUT = WS_WIN + W_IN_B;
static_assert(WS_WOUT + W_OUT_B <= 43 * MiB, "weights");
constexpr size_t WS_XB = 43 * MiB;
constexpr size_t WS_MIX = WS_XB + 32 * MiB;
constexpr size_t WS_BIG = WS_MIX + 32 * MiB;
constexpr size_t WS_GATES = WS_BIG + 112 * MiB;
constexpr size_t WS_SS = WS_GATES + 1 * MiB;
constexpr size_t WS_CST = WS_SS + 1 * MiB;
constexpr size_t WS_NST = WS_CST + 64 * MiB;
constexpr size_t WS_MSC = WS_NST + 1 * MiB;
constexpr size_t WS_OB = WS_MSC + 1 * MiB;
constexpr size_t WS_LSE = WS_OB + 48 * MiB;
constexpr size_t WS_END = WS_LSE + 2 * MiB;
static_assert(WS_END + 32768 <= 340 * MiB, "ws");

constexpr int LDS_BYTES = 147456;

__device__ __forceinline__ int tid_l() { int t = threadIdx.x; asm volatile("" : "+v"(t)); return t; }
typedef __bf16 bf16x2_t __attribute__((ext_vector_type(2)));
__device__ __forceinline__ unsigned cvt_pk_bf16(float lo, float hi) { const f32x2 v = {lo, hi}; const bf16x2_t b = __builtin_convertvector(v, bf16x2_t); return __builtin_bit_cast(unsigned, b); }
__device__ __forceinline__ float bf2f(unsigned h) { return __builtin_bit_cast(float, h << 16); }
__device__ __forceinline__ float bflo(unsigned w) { return __builtin_bit_cast(float, w << 16); }
__device__ __forceinline__ float bfhi(unsigned w) { return __builtin_bit_cast(float, w & 0xffff0000u); }
__device__ __forceinline__ float silu_f(float v) { return v * __builtin_amdgcn_rcpf(1.f + __expf(-v)); }
__device__ __forceinline__ float sigmoid_f(float v) { return __builtin_amdgcn_rcpf(1.f + __expf(-v)); }
typedef short s16x4 __attribute__((ext_vector_type(4)));
__device__ __forceinline__ u32x2 tr_read(const bf16_t* p) { const s16x4 r = __builtin_amdgcn_ds_read_tr16_b64_v4i16((LAS s16x4*)p); return __builtin_bit_cast(u32x2, r); }
__device__ __forceinline__ f32x4 mma16(bf16x8 a, bf16x8 b, f32x4 c) { return __builtin_amdgcn_mfma_f32_16x16x32_bf16(a, b, c, 0, 0, 0); }
__device__ __forceinline__ float rstd_of(const float* ss, int row) {
    const f32x4* p = (const f32x4*)(ss + (size_t)row * 16);
    const f32x4 a = p[0], b = p[1], c = p[2], d = p[3];
    const float s = ((a.x + a.y) + (a.z + a.w)) + ((b.x + b.y) + (b.z + b.w)) + ((c.x + c.y) + (c.z + c.w)) + ((d.x + d.y) + (d.z + d.w));
    return rsqrtf(s * (1.f / 1024.f) + EPS);
}
__device__ __forceinline__ float wave_sum(float v) {
#pragma unroll
    for (int o = 1; o < 64; o <<= 1) v += __shfl_xor(v, o);
    return v;
}
__device__ __forceinline__ float incl_sum(float v, int lane) {
#pragma unroll
    for (int o = 1; o < 64; o <<= 1) { const float t = __shfl_up(v, o); if (lane >= o) v += t; }
    return v;
}
__device__ __forceinline__ float incl_max(float v, int lane) {
#pragma unroll
    for (int o = 1; o < 64; o <<= 1) { const float t = __shfl_up(v, o); if (lane >= o) v = fmaxf(v, t); }
    return v;
}

namespace pg8 {
constexpr int BM = 256, BK = 64, HALF = 128, HTB = HALF * BK * 2, STAGE_BYTES = 8 * HTB, NXCD = 8, WGM = 8;
__host__ __device__ __forceinline__ int lds_byte(int r, int c) { const int st = (r >> 4) * 2 + (c >> 5), rr = r & 15, cc = c & 31, ob = rr * 64 + cc * 2; return st * 1024 + (ob ^ (((ob >> 9) & 1) << 5)); }
__host__ __device__ __forceinline__ void stage_rc(int b, int& R, int& C) { const int st = b / 1024, sb = b % 1024, swz = sb ^ (((sb >> 9) & 1) << 5); R = (st >> 1) * 16 + swz / 64; C = (st & 1) * 32 + (swz % 64) / 2; }
__host__ __device__ __forceinline__ int perm32(int rho) { const int n = rho >> 4, i = rho & 15; return 8 * (i >> 2) + 4 * n + (i & 3); }
struct Unit { int pm, pn, idx; };
struct Gemm { const bf16_t* A; const bf16_t* Bt; int M, N, K; };
struct StaticOrder {
    int nM, nN, nwg, G, c;
    __host__ __device__ void init(int M, int N, int G_, int c_) { nM = M / BM; nN = N / BM; nwg = nM * nN; G = G_; c = c_; }
    __host__ __device__ bool next(int i, Unit& u) const {
        const long L = (long)i * G + c; if (L >= nwg) return false;
        int wgid = (int)L; { const int q = nwg / NXCD, r = nwg % NXCD, xcd = wgid % NXCD, off = wgid / NXCD; wgid = (xcd < r ? xcd * (q + 1) : r * (q + 1) + (xcd - r) * q) + off; }
        const int nig = WGM * nN, gid = wgid / nig, fm = gid * WGM, gsz = (nM - fm) < WGM ? (nM - fm) : WGM;
        u.pm = fm + ((wgid % nig) % gsz); u.pn = (wgid % nig) / gsz; u.idx = i; return true;
    }
    __device__ __forceinline__ void a_ready(const Unit&) const {}
    __device__ __forceinline__ void done(const Unit&) const {}
};


struct EpiUp {
    static constexpr bool PERM = true, AFTER_DRAIN = false;
    bf16_t* H; LAS const float* rtab;
    __device__ __forceinline__ void operator()(const f32x4 (&acc)[2][2][4][2], const Unit& u, int wr, int wc, int fr, int fq) const {
        const int row0 = u.pm * BM + wr * 64 + fr, col0 = u.pn * 128 + wc * 32 + 8 * fq;
#pragma unroll
        for (int ai = 0; ai < 2; ++ai)
#pragma unroll
            for (int m = 0; m < 4; ++m) {
                const int row = row0 + ai * HALF + m * 16; const float r = rtab[u.idx * 256 + ai * HALF + wr * 64 + m * 16 + fr];
                unsigned wv[4];
#pragma unroll
                for (int n = 0; n < 2; ++n) { const f32x4 a = acc[ai][0][m][n] * r, b = acc[ai][1][m][n] * r;
                    wv[2 * n] = cvt_pk_bf16(silu_f(a[0]) * b[0], silu_f(a[1]) * b[1]); wv[2 * n + 1] = cvt_pk_bf16(silu_f(a[2]) * b[2], silu_f(a[3]) * b[3]); }
                const u32x4 w = (u32x4){wv[0], wv[1], wv[2], wv[3]};
                *(u32x4*)(H + (size_t)row * FF + col0) = w;
                __builtin_amdgcn_sched_barrier(0);
            }
    }
};
struct EpiRes {
    static constexpr bool PERM = true, AFTER_DRAIN = false;
    GAS const float* base; GAS float* out; bf16_t* xb; float* ss; float scale;
    __device__ __forceinline__ void operator()(const f32x4 (&acc)[2][2][4][2], const Unit& u, int wr, int wc, int fr, int fq) const {
        const int row0 = u.pm * BM + wr * 64 + fr, col0 = u.pn * BM + wc * 32 + 8 * fq;
#pragma unroll
        for (int ai = 0; ai < 2; ++ai)
#pragma unroll
          for (int mh = 0; mh < 2; ++mh) {
            f32x4 bs[2][2][2];
#pragma unroll
            for (int mi = 0; mi < 2; ++mi) { const size_t off = (size_t)(row0 + ai * HALF + (2 * mh + mi) * 16) * D + col0;
#pragma unroll
                for (int bj = 0; bj < 2; ++bj)
#pragma unroll
                    for (int n = 0; n < 2; ++n) bs[mi][bj][n] = *(GAS const f32x4*)(base + off + bj * HALF + n * 4); }
#pragma unroll
            for (int mi = 0; mi < 2; ++mi) {
                const int m = 2 * mh + mi;
                const int row = row0 + ai * HALF + m * 16; const size_t off = (size_t)row * D + col0; float sq = 0.f;
#pragma unroll
                for (int bj = 0; bj < 2; ++bj) {
                    const f32x4 o0 = bs[mi][bj][0] + acc[ai][bj][m][0] * scale, o1 = bs[mi][bj][1] + acc[ai][bj][m][1] * scale;
                    *(GAS f32x4*)(out + off + bj * HALF) = o0; *(GAS f32x4*)(out + off + bj * HALF + 4) = o1;
                    u32x4 w; w.x = cvt_pk_bf16(o0[0], o0[1]); w.y = cvt_pk_bf16(o0[2], o0[3]); w.z = cvt_pk_bf16(o1[0], o1[1]); w.w = cvt_pk_bf16(o1[2], o1[3]);
                    *(u32x4*)(xb + off + bj * HALF) = w;
                    sq += ((o0[0] * o0[0] + o0[1] * o0[1]) + (o0[2] * o0[2] + o0[3] * o0[3])) + ((o1[0] * o1[0] + o1[1] * o1[1]) + (o1[2] * o1[2] + o1[3] * o1[3]));
                }
                sq += __shfl_xor(sq, 16); sq += __shfl_xor(sq, 32);
                if (fq == 0) ss[(size_t)row * 16 + u.pn * 4 + wc] = sq;
            }
          }
    }
};
struct EpiProj {
    static constexpr bool PERM = true, AFTER_DRAIN = false;
    bf16_t* O; int ldc; LAS const float* rtab; float* gates; int gate_pn;
    __device__ __forceinline__ void operator()(const f32x4 (&acc)[2][2][4][2], const Unit& u, int wr, int wc, int fr, int fq) const {
        const int row0 = u.pm * BM + wr * 64 + fr, col0 = u.pn * BM + wc * 32 + 8 * fq;
#pragma unroll
        for (int ai = 0; ai < 2; ++ai)
#pragma unroll
            for (int m = 0; m < 4; ++m) {
                const int row = row0 + ai * HALF + m * 16; const float r = rtab[u.idx * 256 + ai * HALF + wr * 64 + m * 16 + fr];
                if (u.pn == gate_pn) {
                    if (wc == 0 && fq < 2) { float* g = gates + (size_t)row * 16 + 8 * fq; *(f32x4*)g = acc[ai][0][m][0] * r; *(f32x4*)(g + 4) = acc[ai][0][m][1] * r; }
                } else {
                    bf16_t* rowp = O + (size_t)row * ldc + col0;
#pragma unroll
                    for (int bj = 0; bj < 2; ++bj) { const f32x4 v0 = acc[ai][bj][m][0] * r, v1 = acc[ai][bj][m][1] * r;
                        u32x4 w; w.x = cvt_pk_bf16(v0[0], v0[1]); w.y = cvt_pk_bf16(v0[2], v0[3]); w.z = cvt_pk_bf16(v1[0], v1[1]); w.w = cvt_pk_bf16(v1[2], v1[3]);
                        *(u32x4*)(rowp + bj * HALF) = w; }
                }
            }
    }
};

template <class Epi, class Sched, bool ALIGN_EPI = false, bool SP2 = false>
__device__ __forceinline__ void gemm_phase(LAS unsigned char* lds, const Gemm g, const Sched& S, const Epi& E) {
    const int tid = tid_l(), wid = __builtin_amdgcn_readfirstlane(tid >> 6), lane = tid & 63, wr = wid >> 2, wc = wid & 3, fr = lane & 15, fq = lane >> 4;
    const int K = g.K, nt = K / BK;
    unsigned voffA[2], voffB[2];
#pragma unroll
    for (int i = 0; i < 2; ++i) { int R, C; stage_rc(tid * 16 + i * 8192, R, C); const int Rb = Epi::PERM ? ((R & ~31) + perm32(R & 31)) : R;
        voffA[i] = (unsigned)(R * K + C) * 2u; voffB[i] = (unsigned)(Rb * K + C) * 2u; }
    const size_t kstep = (size_t)(BK * 2);
    const size_t hstep = (size_t)HALF * K * 2;
    const size_t tstep = 2 * hstep;
    const unsigned ldsw = (unsigned)wid * 1024u;
    const int aoff = lds_byte(wr * 64 + fr, fq * 8), boff = lds_byte(wc * 32 + fr, fq * 8);
#define PG8_SA(b, h) (((b) * 2 + (h)) * HTB)
#define PG8_SB(b, h) ((4 + (b) * 2 + (h)) * HTB)
#define PG8_STAGE(bufoff, gbase, voff) do { _Pragma("unroll") for (int _i = 0; _i < 2; ++_i) \
        __builtin_amdgcn_global_load_lds((const unsigned*)((const char*)(gbase) + (voff)[_i]), (LAS unsigned*)(lds + (bufoff) + ldsw + _i * 8192), 16, 0, 0); } while (0)
#define PG8_LDA(dst, b, h) do { _Pragma("unroll") for (int m = 0; m < 4; ++m) _Pragma("unroll") for (int k = 0; k < 2; ++k) dst[m][k] = *(const LAS bf16x8*)(lds + PG8_SA(b, h) + aoff + m * 2048 + k * 1024); } while (0)
#define PG8_LDB(dst, b, h) do { _Pragma("unroll") for (int n = 0; n < 2; ++n) _Pragma("unroll") for (int k = 0; k < 2; ++k) dst[n][k] = *(const LAS bf16x8*)(lds + PG8_SB(b, h) + boff + n * 2048 + k * 1024); } while (0)
#define PG8_MMA(ai, bj, At, Bt) do { __builtin_amdgcn_s_setprio(1); _Pragma("unroll") for (int m = 0; m < 4; ++m) _Pragma("unroll") for (int n = 0; n < 2; ++n) _Pragma("unroll") for (int k = 0; k < 2; ++k) \
        acc[ai][bj][m][n] = __builtin_amdgcn_mfma_f32_16x16x32_bf16(Bt[n][k], At[m][k], acc[ai][bj][m][n], 0, 0, 0); __builtin_amdgcn_s_setprio(0); } while (0)
#define PG8_WAIT_V(n) asm volatile("s_waitcnt vmcnt(" #n ")" ::: "memory")
#define PG8_WAIT_L(n) asm volatile("s_waitcnt lgkmcnt(" #n ")" ::: "memory")
#define PG8_BAR __builtin_amdgcn_s_barrier()
#define PG8_SCHED __builtin_amdgcn_sched_barrier(0)
    Unit cur, nxt; int ui = 0;
    if (!S.next(0, cur)) return;
    f32x4 acc[2][2][4][2];
#pragma unroll
    for (int a = 0; a < 2; ++a)
#pragma unroll
        for (int b = 0; b < 2; ++b)
#pragma unroll
            for (int m = 0; m < 4; ++m)
#pragma unroll
                for (int n = 0; n < 2; ++n) acc[a][b][m][n] = (f32x4){0.f, 0.f, 0.f, 0.f};
    bf16x8 At[4][2], B0[2][2], B1[2][2];
    const char* cA = (const char*)g.A + (size_t)cur.pm * tstep; const char* cB = (const char*)g.Bt + (size_t)cur.pn * tstep;
    S.a_ready(cur);
    if constexpr (SP2) {
        PG8_STAGE(PG8_SB(0, 0), cB, voffB); PG8_STAGE(PG8_SB(0, 1), cB + hstep, voffB); PG8_STAGE(PG8_SA(0, 0), cA, voffA); PG8_STAGE(PG8_SA(0, 1), cA + hstep, voffA);
        if (wr == 1) PG8_BAR;
        PG8_WAIT_V(2); PG8_BAR;
        PG8_STAGE(PG8_SB(1, 0), cB + kstep, voffB); PG8_STAGE(PG8_SA(1, 0), cA + kstep, voffA); PG8_STAGE(PG8_SB(1, 1), cB + hstep + kstep, voffB);
        PG8_WAIT_V(6); PG8_BAR;
    } else {
        PG8_STAGE(PG8_SB(0, 0), cB, voffB); PG8_STAGE(PG8_SA(0, 0), cA, voffA); PG8_STAGE(PG8_SB(0, 1), cB + hstep, voffB); PG8_STAGE(PG8_SA(0, 1), cA + hstep, voffA);
        if (wr == 1) PG8_BAR;
        PG8_WAIT_V(4); PG8_BAR;
        PG8_STAGE(PG8_SB(1, 0), cB + kstep, voffB); PG8_STAGE(PG8_SA(1, 0), cA + kstep, voffA); PG8_STAGE(PG8_SB(1, 1), cB + hstep + kstep, voffB);
        PG8_WAIT_V(6); PG8_BAR;
    }
    for (;;) {
        const bool has_next = S.next(ui + 1, nxt);
        const char* nA = has_next ? (const char*)g.A + (size_t)nxt.pm * tstep : cA; const char* nB = has_next ? (const char*)g.Bt + (size_t)nxt.pn * tstep : cB;
        for (int t = 0; t < nt; t += 2) {
            const bool last = (t == nt - 2);
            const char* a1 = cA + (size_t)(t + 1) * kstep;
            const char* a2 = last ? nA : cA + (size_t)(t + 2) * kstep; const char* b2 = last ? nB : cB + (size_t)(t + 2) * kstep;
            const char* a3 = a2 + kstep; const char* b3 = b2 + kstep;
            if (last && has_next) S.a_ready(nxt);
            if constexpr (SP2) {
            PG8_LDB(B0, 0, 0); PG8_LDB(B1, 0, 1); PG8_SCHED; PG8_LDA(At, 0, 0); PG8_STAGE(PG8_SA(1, 1), a1 + hstep, voffA);
            PG8_WAIT_V(8); PG8_WAIT_L(0); PG8_BAR; PG8_MMA(0, 0, At, B0); PG8_MMA(0, 1, At, B1); PG8_BAR; PG8_SCHED;
            PG8_LDA(At, 0, 1); PG8_STAGE(PG8_SB(0, 0), b2, voffB); PG8_STAGE(PG8_SB(0, 1), b2 + hstep, voffB); PG8_STAGE(PG8_SA(0, 0), a2, voffA);
            PG8_WAIT_V(8); PG8_WAIT_L(0); PG8_BAR; PG8_MMA(1, 0, At, B0); PG8_MMA(1, 1, At, B1); PG8_BAR; PG8_SCHED;
            PG8_LDB(B0, 1, 0); PG8_LDB(B1, 1, 1); PG8_SCHED; PG8_LDA(At, 1, 0); PG8_STAGE(PG8_SA(0, 1), a2 + hstep, voffA);
            PG8_WAIT_V(8); PG8_WAIT_L(0); PG8_BAR; PG8_MMA(0, 0, At, B0); PG8_MMA(0, 1, At, B1); PG8_BAR; PG8_SCHED;
            PG8_LDA(At, 1, 1); PG8_STAGE(PG8_SB(1, 0), b3, voffB); PG8_STAGE(PG8_SB(1, 1), b3 + hstep, voffB); PG8_STAGE(PG8_SA(1, 0), a3, voffA);
            PG8_WAIT_V(8); PG8_WAIT_L(0); PG8_BAR; PG8_MMA(1, 0, At, B0); PG8_MMA(1, 1, At, B1); PG8_BAR; PG8_SCHED;
            } else {
            PG8_LDB(B0, 0, 0); PG8_SCHED; PG8_LDA(At, 0, 0); PG8_STAGE(PG8_SA(1, 1), a1 + hstep, voffA);
            PG8_WAIT_L(8); PG8_BAR; PG8_WAIT_L(0); PG8_MMA(0, 0, At, B0); PG8_BAR; PG8_SCHED;
            PG8_LDB(B1, 0, 1); PG8_STAGE(PG8_SB(0, 0), b2, voffB);
            PG8_BAR; PG8_WAIT_L(0); PG8_MMA(0, 1, At, B1); PG8_BAR;
            PG8_LDA(At, 0, 1); PG8_STAGE(PG8_SA(0, 0), a2, voffA);
            PG8_BAR; PG8_WAIT_L(0); PG8_MMA(1, 0, At, B0); PG8_BAR; PG8_SCHED;
            PG8_STAGE(PG8_SB(0, 1), b2 + hstep, voffB);
            PG8_WAIT_V(6); PG8_BAR; PG8_MMA(1, 1, At, B1); PG8_BAR;
            PG8_LDB(B0, 1, 0); PG8_SCHED; PG8_LDA(At, 1, 0); PG8_STAGE(PG8_SA(0, 1), a2 + hstep, voffA);
            PG8_WAIT_L(8); PG8_BAR; PG8_WAIT_L(0); PG8_MMA(0, 0, At, B0); PG8_BAR; PG8_SCHED;
            PG8_LDB(B1, 1, 1); PG8_STAGE(PG8_SB(1, 0), b3, voffB);
            PG8_BAR; PG8_WAIT_L(0); PG8_MMA(0, 1, At, B1); PG8_BAR;
            PG8_LDA(At, 1, 1); PG8_STAGE(PG8_SA(1, 0), a3, voffA);
            PG8_BAR; PG8_WAIT_L(0); PG8_MMA(1, 0, At, B0); PG8_BAR; PG8_SCHED;
            PG8_STAGE(PG8_SB(1, 1), b3 + hstep, voffB);
            PG8_WAIT_V(6); PG8_BAR; PG8_MMA(1, 1, At, B1); PG8_BAR;
            }
        }
        if constexpr (ALIGN_EPI) { if (wr == 0) PG8_BAR; }
        if constexpr (!Epi::AFTER_DRAIN) { E(acc, cur, wr, wc, fr, fq); S.done(cur); }
        if (!has_next) break;
#pragma unroll
        for (int a = 0; a < 2; ++a)
#pragma unroll
            for (int b = 0; b < 2; ++b)
#pragma unroll
                for (int m = 0; m < 4; ++m)
#pragma unroll
                    for (int n = 0; n < 2; ++n) acc[a][b][m][n] = (f32x4){0.f, 0.f, 0.f, 0.f};
        cur = nxt; cA = nA; cB = nB; ++ui;
        if constexpr (ALIGN_EPI) { if (wr == 1) PG8_BAR; }
    }
    PG8_WAIT_V(0);
    if constexpr (!ALIGN_EPI) { if (wr == 0) PG8_BAR; }
    PG8_BAR;
#undef PG8_SA
#undef PG8_SB
#undef PG8_STAGE
#undef PG8_LDA
#undef PG8_LDB
#undef PG8_MMA
#undef PG8_WAIT_V
#undef PG8_WAIT_L
#undef PG8_BAR
#undef PG8_SCHED
}
constexpr int LDS_RTAB = STAGE_BYTES;
__device__ __forceinline__ void fill_rstd(LAS unsigned char* lds, const float* ss, const StaticOrder& S) {
    LAS float* tab = (LAS float*)(lds + LDS_RTAB);
    const int tid = tid_l(), rl = tid >> 1, half = tid & 1;
#pragma unroll 1
    for (int i = 0; i < 8; ++i) {
        Unit u; if (!S.next(i, u)) break;
        const f32x4* p = (const f32x4*)(ss + (size_t)(u.pm * BM + rl) * 16 + half * 8);
        const f32x4 a = p[0], b = p[1];
        float sm = ((a.x + a.y) + (a.z + a.w)) + ((b.x + b.y) + (b.z + b.w));
        sm += __shfl_xor(sm, 1);
        if (half == 0) tab[i * 256 + rl] = rsqrtf(sm * (1.f / 1024.f) + EPS);
    }
    __syncthreads();
}
}

struct Args {
    const float* in[15]; float* out; unsigned char* ws; int ph_lo, ph_hi;
};
struct Ctx { unsigned char* ws; int G, bid; };
constexpr size_t WS_TAB = WS_END;
#define INP(k) ((const float*)(GAS const float*)(((const float* const*)(X.ws + WS_TAB))[k]))
#define X_x INP(0)
#define X_norm_g INP(1)
#define X_w1 INP(2)
#define X_w3 INP(3)
#define X_w2 INP(4)
#define X_ab_w_in INP(5)
#define X_ab_conv_w INP(6)
#define X_ab_conv_b INP(7)
#define X_ab_gate_b INP(8)
#define X_ab_hnorm_g INP(9)
#define X_ab_w_out INP(10)
#define X_c_w_in INP(11)
#define X_c_sink INP(12)
#define X_c_w_out INP(13)
#define X_final_g INP(14)
#define X_out ((float*)(GAS float*)(((float* const*)(X.ws + WS_TAB))[15]))
#define WSP(TY, off) ((TY*)(X.ws + (off)))
#define X_Wup1 WSP(bf16_t, WS_WUP1)
#define X_Wdn1 WSP(bf16_t, WS_WDN1)
#define X_Wup2 WSP(bf16_t, WS_WUP2)
#define X_Wdn2 WSP(bf16_t, WS_WDN2)
#define X_Win WSP(bf16_t, WS_WIN)
#define X_Wout WSP(bf16_t, WS_WOUT)
#define X_xb WSP(bf16_t, WS_XB)
#define X_mix WSP(bf16_t, WS_MIX)
#define X_big WSP(bf16_t, WS_BIG)
#define X_qc WSP(bf16_t, WS_XB)
#define X_kc WSP(bf16_t, WS_XB + (size_t)T * 512 * 2)
#define X_cst WSP(bf16_t, WS_CST)
#define X_ob WSP(bf16_t, WS_OB)
#define X_gates WSP(float, WS_GATES)
#define X_ss WSP(float, WS_SS)
#define X_nst WSP(float, WS_NST)
#define X_mc WSP(float, WS_MSC)
#define X_bc WSP(float, WS_MSC + 8192)
#define X_mprev WSP(float, WS_MSC + 16384)
#define X_lse WSP(float, WS_LSE)

__device__ __forceinline__ int wrow_map(int mode, int n) {
    if (mode == 1) return ((n >> 7) << 8) + (n & 127);
    if (mode == 2) return ((n >> 7) << 8) + 128 + (n & 127);
    if (mode == 3) return n < 2048 ? n : (n < 2064 ? 3584 + (n - 2048) : n - 16);
    return n;
}
__device__ __forceinline__ void transpose_item(const float* Wg, int K, int N, bf16_t* WT, int mode, const float* gg, float* scr, int item, int lane) {
    GAS const float* W = (GAS const float*)Wg; GAS const float* g = (GAS const float*)gg;
    const int nblk = (N + 63) >> 6, kb = item / nblk, nb = item - kb * nblk, k0 = 64 * kb, n0 = 64 * nb;
    const int c4 = 4 * (lane & 15), rr = lane >> 4; const bool colok = (n0 + c4) < N;
    f32x4 v[16];
#pragma unroll
    for (int i = 0; i < 16; ++i) { v[i] = (f32x4){0.f, 0.f, 0.f, 0.f}; if (colok) v[i] = *(GAS const f32x4*)(W + (size_t)(k0 + 4 * i + rr) * N + n0 + c4); }
    if (gg) {
#pragma unroll
        for (int i = 0; i < 16; ++i) v[i] = v[i] * g[k0 + 4 * i + rr];
    }
#pragma unroll
    for (int i = 0; i < 16; ++i) *(f32x4*)(scr + (4 * i + rr) * 68 + c4) = v[i];
    asm volatile("s_waitcnt lgkmcnt(0)" ::: "memory");
    const int c = lane & 7;
#pragma unroll
    for (int j = 0; j < 8; ++j) { const int n = (lane >> 3) + 8 * j; const float* sp = scr + (8 * c) * 68 + n;
        if (n0 + n < N) {
            u32x4 o; o.x = cvt_pk_bf16(sp[0 * 68], sp[1 * 68]); o.y = cvt_pk_bf16(sp[2 * 68], sp[3 * 68]); o.z = cvt_pk_bf16(sp[4 * 68], sp[5 * 68]); o.w = cvt_pk_bf16(sp[6 * 68], sp[7 * 68]);
            *(u32x4*)(WT + (size_t)wrow_map(mode, n0 + n) * K + k0 + 8 * c) = o; } }
    asm volatile("s_waitcnt lgkmcnt(0)" ::: "memory");
}
__device__ __forceinline__ void phase_convert(unsigned char* lds, const Ctx& X, int l, int parts, int gwg, int nwg_part) {
    const int tid = tid_l(), lane = tid & 63, wave = tid >> 6;
    float* scr = (float*)(lds + wave * 17408);
    const int gw = gwg * 8 + wave, NGW = nwg_part * 8;
    const int j = l >> 1; const bool even = (l & 1) == 0;
    constexpr int I_UP = (D / 64) * (FF / 64), I_DN = (FF / 64) * (D / 64);
    const int Nin = even ? 3600 : C_N; const int I_IN = (D / 64) * ((Nin + 63) / 64); constexpr int I_OUT = (D / 64) * (D / 64);
    const int NA = (parts & 1) ? (2 * I_UP + I_DN + I_IN + I_OUT) : 0, NB = (parts & 2) ? (2 * I_UP + I_DN) : 0;
    const float* g0 = X_norm_g + (size_t)(l * 3 + 0) * D; const float* g1 = X_norm_g + (size_t)(l * 3 + 1) * D; const float* g2 = X_norm_g + (size_t)(l * 3 + 2) * D;
    const size_t wff = (size_t)D * FF;
    for (int it = gw; it < NA + NB; it += NGW) {
        int r = it;
        if (r < NA) {
            if (r < I_UP) { transpose_item(X_w1 + (size_t)(l * 2 + 0) * wff, D, FF, X_Wup1, 1, g0, scr, r, lane); continue; } r -= I_UP;
            if (r < I_UP) { transpose_item(X_w3 + (size_t)(l * 2 + 0) * wff, D, FF, X_Wup1, 2, g0, scr, r, lane); continue; } r -= I_UP;
            if (r < I_DN) { transpose_item(X_w2 + (size_t)(l * 2 + 0) * wff, FF, D, X_Wdn1, 0, nullptr, scr, r, lane); continue; } r -= I_DN;
            if (r < I_IN) { if (even) transpose_item(X_ab_w_in + (size_t)j * D * 3600, D, 3600, X_Win, 3, g1, scr, r, lane);
                            else transpose_item(X_c_w_in + (size_t)j * D * C_N, D, C_N, X_Win, 0, g1, scr, r, lane); continue; } r -= I_IN;
            transpose_item((even ? X_ab_w_out : X_c_w_out) + (size_t)j * D * D, D, D, X_Wout, 0, nullptr, scr, r, lane); continue;
        }
        r -= NA;
        if (r < I_UP) { transpose_item(X_w1 + (size_t)(l * 2 + 1) * wff, D, FF, X_Wup2, 1, g2, scr, r, lane); continue; } r -= I_UP;
        if (r < I_UP) { transpose_item(X_w3 + (size_t)(l * 2 + 1) * wff, D, FF, X_Wup2, 2, g2, scr, r, lane); continue; } r -= I_UP;
        transpose_item(X_w2 + (size_t)(l * 2 + 1) * wff, FF, D, X_Wdn2, 0, nullptr, scr, r, lane);
    }
    if (even && (parts & 1)) {
        u32x4* z = (u32x4*)(X_Win + (size_t)3600 * D); const int n16 = 240 * D * 2 / 16;
        for (int i = gwg * NTHREADS + tid; i < n16; i += nwg_part * NTHREADS) z[i] = (u32x4){0u, 0u, 0u, 0u};
    }
}
__device__ __forceinline__ void convert_in_tail(unsigned char* lds, const Ctx& X, int l, int parts, int nunits) {
    const int rounds = (nunits + X.G - 1) / X.G; const int n_full = nunits - (rounds - 1) * X.G;
    if (n_full >= X.G) { phase_convert(lds, X, l, parts, X.bid, X.G); return; }
    if (X.bid >= n_full) phase_convert(lds, X, l, parts, X.bid - n_full, X.G - n_full);
}
__device__ __forceinline__ void phase_init(const Ctx& X) {
    const int tid = tid_l(), lane = tid & 63, wave = tid >> 6;
    const int gw = X.bid * 8 + wave, NGW = X.G * 8;
    for (int m = gw; m < T; m += 2 * NGW) {
        const int m2 = (m + NGW < T) ? m + NGW : m;
        GAS const f32x4* xa = (GAS const f32x4*)(X_x + (size_t)m * D) + lane; GAS const f32x4* xc = (GAS const f32x4*)(X_x + (size_t)m2 * D) + lane;
        f32x4 va[4], vc[4];
#pragma unroll
        for (int j = 0; j < 4; ++j) { va[j] = xa[64 * j]; vc[j] = xc[64 * j]; }
        u32x2* oa = (u32x2*)(X_xb + (size_t)m * D) + lane; u32x2* oc = (u32x2*)(X_xb + (size_t)m2 * D) + lane; float sa = 0.f, sc = 0.f;
#pragma unroll
        for (int j = 0; j < 4; ++j) {
            sa += (va[j].x * va[j].x + va[j].y * va[j].y) + (va[j].z * va[j].z + va[j].w * va[j].w); sc += (vc[j].x * vc[j].x + vc[j].y * vc[j].y) + (vc[j].z * vc[j].z + vc[j].w * vc[j].w);
            u32x2 w; w.x = cvt_pk_bf16(va[j].x, va[j].y); w.y = cvt_pk_bf16(va[j].z, va[j].w); oa[64 * j] = w;
            if (m2 != m) { u32x2 y; y.x = cvt_pk_bf16(vc[j].x, vc[j].y); y.y = cvt_pk_bf16(vc[j].z, vc[j].w); oc[64 * j] = y; }
        }
        sa = wave_sum(sa); sc = wave_sum(sc);
        if (lane < 16) { X_ss[(size_t)m * 16 + lane] = lane == 0 ? sa : 0.f; if (m2 != m) X_ss[(size_t)m2 * 16 + lane] = lane == 0 ? sc : 0.f; }
    }
}
__device__ __forceinline__ void phase_final(const Ctx& X) {
    const int tid = tid_l(), lane = tid & 63, wave = tid >> 6;
    const int gw = X.bid * 8 + wave, NGW = X.G * 8;
    GAS const f32x4* gr = (GAS const f32x4*)X_final_g + lane;
    for (int m = gw; m < T; m += 2 * NGW) {
        const int m2 = (m + NGW < T) ? m + NGW : m;
        GAS f32x4* xa = (GAS f32x4*)(X_out + (size_t)m * D) + lane; GAS f32x4* xc = (GAS f32x4*)(X_out + (size_t)m2 * D) + lane;
        f32x4 va[4], vc[4]; float sa = 0.f, sc = 0.f;
#pragma unroll
        for (int j = 0; j < 4; ++j) { va[j] = xa[64 * j]; vc[j] = xc[64 * j]; }
#pragma unroll
        for (int j = 0; j < 4; ++j) { sa += (va[j].x * va[j].x + va[j].y * va[j].y) + (va[j].z * va[j].z + va[j].w * va[j].w); sc += (vc[j].x * vc[j].x + vc[j].y * vc[j].y) + (vc[j].z * vc[j].z + vc[j].w * vc[j].w); }
        const float ra = rsqrtf(wave_sum(sa) * (1.f / 1024.f) + EPS), rc = rsqrtf(wave_sum(sc) * (1.f / 1024.f) + EPS);
#pragma unroll
        for (int j = 0; j < 4; ++j) { const f32x4 g = gr[64 * j]; xa[64 * j] = va[j] * ra * g; if (m2 != m) xc[64 * j] = vc[j] * rc * g; }
    }
}

__device__ __forceinline__ void phase_conv(const Ctx& X, int j) {
    const float* cw = X_ab_conv_w + (size_t)j * 5 * 1024; const float* cb = X_ab_conv_b + (size_t)j * 1024;
    const int nitems = T * 128;
    const int idx0 = X.bid * NTHREADS + tid_l(); const int step = X.G * NTHREADS;
    if ((step & 127) == 0) {
        const int c0 = (idx0 & 127) * 8; const bool isk = c0 >= 512; const float sc = isk ? 0.08838834764831845f : 1.f;
        f32x4 w0[5], w1[5];
#pragma unroll
        for (int k = 0; k < 5; ++k) { w0[k] = *(const f32x4*)(cw + k * 1024 + c0); w1[k] = *(const f32x4*)(cw + k * 1024 + c0 + 4); }
        const f32x4 b0 = *(const f32x4*)(cb + c0), b1 = *(const f32x4*)(cb + c0 + 4);
        for (int idx = idx0; idx < nitems; idx += step) {
            const int t = idx >> 7, tt = t & (SEQ - 1);
            u32x4 v[5];
#pragma unroll
            for (int k = 0; k < 5; ++k) { const int tp = tt + k - 2; v[k] = (u32x4){0u, 0u, 0u, 0u}; if (tp >= 0 && tp < SEQ) v[k] = *(const u32x4*)(X_big + (size_t)(t + k - 2) * AB_LD + PC_QK + c0); }
            float a[8] = {b0.x, b0.y, b0.z, b0.w, b1.x, b1.y, b1.z, b1.w};
#pragma unroll
            for (int k = 0; k < 5; ++k) {
                a[0] += bflo(v[k].x) * w0[k].x; a[1] += bfhi(v[k].x) * w0[k].y; a[2] += bflo(v[k].y) * w0[k].z; a[3] += bfhi(v[k].y) * w0[k].w;
                a[4] += bflo(v[k].z) * w1[k].x; a[5] += bfhi(v[k].z) * w1[k].y; a[6] += bflo(v[k].w) * w1[k].z; a[7] += bfhi(v[k].w) * w1[k].w;
            }
#pragma unroll
            for (int i = 0; i < 8; ++i) a[i] = silu_f(a[i]) * sc;
            u32x4 o; o.x = cvt_pk_bf16(a[0], a[1]); o.y = cvt_pk_bf16(a[2], a[3]); o.z = cvt_pk_bf16(a[4], a[5]); o.w = cvt_pk_bf16(a[6], a[7]);
            bf16_t* dst = isk ? (X_kc + (size_t)t * 512 + (c0 - 512)) : (X_qc + (size_t)t * 512 + c0);
            *(u32x4*)dst = o;
        }
        return;
    }
    for (int idx = idx0; idx < nitems; idx += step) {
        const int t = idx >> 7, c0 = (idx & 127) * 8, tt = t & (SEQ - 1);
        float a[8];
#pragma unroll
        for (int i = 0; i < 8; ++i) a[i] = cb[c0 + i];
#pragma unroll
        for (int k = 0; k < 5; ++k) {
            const int tp = tt + k - 2;
            if (tp >= 0 && tp < SEQ) {
                const u32x4 v = *(const u32x4*)(X_big + (size_t)(t + k - 2) * AB_LD + PC_QK + c0);
                const f32x4 w0 = *(const f32x4*)(cw + k * 1024 + c0), w1 = *(const f32x4*)(cw + k * 1024 + c0 + 4);
                a[0] += bflo(v.x) * w0.x; a[1] += bfhi(v.x) * w0.y; a[2] += bflo(v.y) * w0.z; a[3] += bfhi(v.y) * w0.w;
                a[4] += bflo(v.z) * w1.x; a[5] += bfhi(v.z) * w1.y; a[6] += bflo(v.w) * w1.z; a[7] += bfhi(v.w) * w1.w;
            }
        }
        const bool isk = c0 >= 512; const float sc = isk ? 0.08838834764831845f : 1.f;
#pragma unroll
        for (int i = 0; i < 8; ++i) a[i] = silu_f(a[i]) * sc;
        u32x4 o; o.x = cvt_pk_bf16(a[0], a[1]); o.y = cvt_pk_bf16(a[2], a[3]); o.z = cvt_pk_bf16(a[4], a[5]); o.w = cvt_pk_bf16(a[6], a[7]);
        bf16_t* dst = isk ? (X_kc + (size_t)t * 512 + (c0 - 512)) : (X_qc + (size_t)t * 512 + c0);
        *(u32x4*)dst = o;
    }
}

struct AttnDesc { int row_base, dil, L, l0, hsel, di; };
template <bool ISB> struct AttnPtr {
    static __device__ __forceinline__ const bf16_t* Q(const Ctx& X, const AttnDesc& d) { return ISB ? X_big + PC_QB + d.hsel * 64 : X_big + d.hsel * 256; }
    static __device__ __forceinline__ const bf16_t* K(const Ctx& X, const AttnDesc& d) { return ISB ? X_big + PC_KB + d.hsel * 64 : X_big + 1024 + d.hsel * 64; }
    static __device__ __forceinline__ const bf16_t* V(const Ctx& X, const AttnDesc& d) { return ISB ? X_big + PC_VB + d.hsel * 64 : X_big + 1280 + d.hsel * 64; }
    static __device__ __forceinline__ bf16_t* O(const Ctx& X, const AttnDesc& d) { return ISB ? X_ob + (size_t)d.di * T * 512 + d.hsel * 64 : X_mix + d.hsel * 256; }
    static __device__ __forceinline__ float* LSE(const Ctx& X, const AttnDesc& d) { return X_lse + (size_t)d.di * T * 8 + d.hsel; }
    static constexpr int ldq = ISB ? AB_LD : C_N, ldkv = ldq, ldo = ISB ? 512 : 1024;
    static __device__ __forceinline__ int head0(const AttnDesc& d) { return ISB ? d.hsel : d.hsel * 4; }
};
template <int RAD> struct AttnGeo {
    static constexpr int NKS = (2 * RAD + 16 + 31) / 32;
    static constexpr int NKT = 2 * NKS;
    static constexpr int NKL = 112 + NKT * 16;
    static constexpr int KST = 72, VST = 72;
    static constexpr int NP = (NKL * 8 + NTHREADS - 1) / NTHREADS;
};
template <int RAD, bool ISB>
__device__ __forceinline__ void attn_load(const Ctx& X, const AttnDesc& d, int tid, u32x4 (&kr)[AttnGeo<RAD>::NP], u32x4 (&vr)[AttnGeo<RAD>::NP]) {
    using Gm = AttnGeo<RAD>; using P = AttnPtr<ISB>; const bf16_t* Kp = P::K(X, d); const bf16_t* Vp = P::V(X, d);
#pragma unroll
    for (int i = 0; i < Gm::NP; ++i) {
        const int p = tid + i * NTHREADS; const int jj = p >> 3, dc = p & 7; const int l = d.l0 - RAD + jj;
        kr[i] = (u32x4){0u, 0u, 0u, 0u}; vr[i] = (u32x4){0u, 0u, 0u, 0u};
        if (p < Gm::NKL * 8 && l >= 0 && l < d.L && jj < 128 + 2 * RAD) { const size_t row = (size_t)d.row_base + (size_t)l * d.dil; kr[i] = *(const u32x4*)(Kp + row * P::ldkv + dc * 8); vr[i] = *(const u32x4*)(Vp + row * P::ldkv + dc * 8); }
    }
}
template <int RAD>
__device__ __forceinline__ void attn_store(unsigned char* lds, int tid, const u32x4 (&kr)[AttnGeo<RAD>::NP], const u32x4 (&vr)[AttnGeo<RAD>::NP]) {
    using Gm = AttnGeo<RAD>;
    bf16_t* Ks = (bf16_t*)lds; bf16_t* Vs = Ks + Gm::NKL * Gm::KST;
#pragma unroll
    for (int i = 0; i < Gm::NP; ++i) {
        const int p = tid + i * NTHREADS; const int jj = p >> 3, dc = p & 7;
        if (p < Gm::NKL * 8) { *(u32x4*)(Ks + jj * Gm::KST + dc * 8) = kr[i]; *(u32x4*)(Vs + jj * Gm::VST + dc * 8) = vr[i]; }
    }
}
template <int RAD, bool SINK, bool ISB, bool TAB>
__device__ __forceinline__ void attn_head(const unsigned char* lds, const Ctx& X, const AttnDesc& d, int g, bf16x8 q0, bf16x8 q1, float sscale, const float* sinkp, int wid, int fr, int fq, const float (&arf)[AttnGeo<RAD>::NKT][4], bool edge) {
    using Gm = AttnGeo<RAD>; constexpr int NKT = Gm::NKT, NKS = Gm::NKS, KST = Gm::KST, VST = Gm::VST;
    const bf16_t* Ks = (const bf16_t*)lds; const bf16_t* Vs = Ks + Gm::NKL * KST;
    const int lq = d.l0 + 16 * wid + fr; const size_t qrow = (size_t)d.row_base + (size_t)lq * d.dil;
    using P = AttnPtr<ISB>;
    __builtin_amdgcn_sched_barrier(0);
    constexpr float L2E = 1.4426950408889634f;
    const float slope = exp2f(-sscale * (float)(P::head0(d) + g + 1)) * (float)d.dil * L2E;
    const float sinkv = SINK ? sinkp[P::head0(d) + g] * L2E : 0.f;
    f32x4 s[NKT];
#pragma unroll
    for (int kt = 0; kt < NKT; ++kt) {
        const bf16_t* kr = Ks + (16 * wid + 16 * kt + fr) * KST + 8 * fq;
        f32x4 c = (f32x4){0.f, 0.f, 0.f, 0.f};
        c = mma16(*(const bf16x8*)kr, q0, c); c = mma16(*(const bf16x8*)(kr + 32), q1, c);
        s[kt] = c;
        if (!ISB) __builtin_amdgcn_sched_barrier(0);
    }
    float mx = SINK ? sinkv : -1e30f;
    if (TAB && !edge) {
#pragma unroll
        for (int kt = 0; kt < NKT; ++kt)
#pragma unroll
            for (int r = 0; r < 4; ++r) { const float v = fmaf(s[kt][r], 0.125f * L2E, -slope * arf[kt][r]); s[kt][r] = v; mx = fmaxf(mx, v); }
    } else {
        int frm = fr, lqm = lq; asm volatile("" : "+v"(frm), "+v"(lqm));
#pragma unroll
        for (int kt = 0; kt < NKT; ++kt)
#pragma unroll
            for (int r = 0; r < 4; ++r) {
                const int jl = 16 * kt + 4 * fq + r; const int rel = jl - RAD - frm; const int lk = lqm + rel; const int ar = rel < 0 ? -rel : rel;
                const bool ok = (ar <= RAD) && (lk >= 0) && (lk < d.L);
                const float v = ok ? fmaf(s[kt][r], 0.125f * L2E, -slope * (float)ar) : -1e30f;
                s[kt][r] = v; mx = fmaxf(mx, v);
            }
    }
    mx = fmaxf(mx, __shfl_xor(mx, 16)); mx = fmaxf(mx, __shfl_xor(mx, 32));
    float den = 0.f;
#pragma unroll
    for (int kt = 0; kt < NKT; ++kt)
#pragma unroll
        for (int r = 0; r < 4; ++r) { const float p = __builtin_amdgcn_exp2f(s[kt][r] - mx); s[kt][r] = p; den += p; }
    den += __shfl_xor(den, 16); den += __shfl_xor(den, 32);
    if (SINK) den += __builtin_amdgcn_exp2f(sinkv - mx);
    f32x4 o[4];
#pragma unroll
    for (int db = 0; db < 4; ++db) o[db] = (f32x4){0.f, 0.f, 0.f, 0.f};
#pragma unroll
    for (int ks = 0; ks < NKS; ++ks) {
        u32x4 pw; pw.x = cvt_pk_bf16(s[2 * ks][0], s[2 * ks][1]); pw.y = cvt_pk_bf16(s[2 * ks][2], s[2 * ks][3]); pw.z = cvt_pk_bf16(s[2 * ks + 1][0], s[2 * ks + 1][1]); pw.w = cvt_pk_bf16(s[2 * ks + 1][2], s[2 * ks + 1][3]);
        const bf16x8 pf = __builtin_bit_cast(bf16x8, pw);
#pragma unroll
        for (int db = 0; db < 4; ++db) {
            const bf16_t* vr = Vs + (16 * wid + 32 * ks + 4 * fq + (fr >> 2)) * VST + 16 * db + 4 * (fr & 3);
            const u32x2 lo = tr_read(vr), hi = tr_read(vr + 16 * VST);
            const u32x4 aw = (u32x4){lo.x, lo.y, hi.x, hi.y};
            o[db] = mma16(__builtin_bit_cast(bf16x8, aw), pf, o[db]);
        }
        if (!ISB) __builtin_amdgcn_sched_barrier(0);
    }
    const float inv = 1.f / den;
#pragma unroll
    for (int db = 0; db < 4; ++db) { u32x2 w; w.x = cvt_pk_bf16(o[db][0] * inv, o[db][1] * inv); w.y = cvt_pk_bf16(o[db][2] * inv, o[db][3] * inv);
        *(u32x2*)(P::O(X, d) + qrow * P::ldo + g * 64 + 16 * db + 4 * fq) = w; }
    if (ISB && fq == 0) P::LSE(X, d)[qrow * 8] = (mx + __log2f(den)) * 0.6931471805599453f;
}
__device__ __forceinline__ void decode_b(int uu, AttnDesc& d) {
    const int di = uu >> 10; int r = uu & 1023; const int h = r & 7; r >>= 3;
    const int dl = di == 0 ? 1 : (di == 1 ? 4 : 16); const int nqb = 64 / dl; const int n = r / nqb, qb = r - n * nqb;
    const int batch = n / dl, res = n - batch * dl;
    d.row_base = batch * SEQ + res; d.dil = dl; d.L = SEQ / dl; d.l0 = qb * 128; d.hsel = h; d.di = di;
}
__device__ __forceinline__ void decode_c(int uu, AttnDesc& d) {
    const int qb = uu & 63, kvh = (uu >> 6) & 3, batch = uu >> 8;
    d.row_base = batch * SEQ; d.dil = 1; d.L = SEQ; d.l0 = qb * 128; d.hsel = kvh; d.di = 0;
}
template <int RAD, int G, bool SINK, bool ISB>
__device__ __forceinline__ void phase_attn(unsigned char* lds, const Ctx& X, int nunits, float sscale, const float* sinkp) {
    using Gm = AttnGeo<RAD>; constexpr bool TAB = ISB;
    const int tid = tid_l(), lane = tid & 63, wid = tid >> 6, fr = lane & 15, fq = lane >> 4;
    float arf[Gm::NKT][4];
#pragma unroll
    for (int kt = 0; kt < Gm::NKT; ++kt)
#pragma unroll
        for (int r = 0; r < 4; ++r) { const int rel = 16 * kt + 4 * fq + r - RAD - fr; const int ar = rel < 0 ? -rel : rel; arf[kt][r] = TAB ? ((ar <= RAD) ? (float)ar : 1e30f) : 0.f; }
    u32x4 kr[Gm::NP], vr[Gm::NP];
    AttnDesc d, dn;
    int uu = X.bid;
    bf16x8 qa0 = {0, 0, 0, 0, 0, 0, 0, 0}, qa1 = qa0;
    if (uu < nunits) {
        if (ISB) decode_b(uu, d); else decode_c(uu, d); attn_load<RAD, ISB>(X, d, tid, kr, vr);
        const size_t qrow = (size_t)d.row_base + (size_t)(d.l0 + 16 * wid + fr) * d.dil; const bf16_t* qp = AttnPtr<ISB>::Q(X, d) + qrow * AttnPtr<ISB>::ldq + 8 * fq;
        qa0 = *(const bf16x8*)qp; qa1 = *(const bf16x8*)(qp + 32);
    }
    for (; uu < nunits; uu += X.G) {
        attn_store<RAD>(lds, tid, kr, vr);
        __syncthreads();
        const bf16_t* qptr; { const size_t qrow = (size_t)d.row_base + (size_t)(d.l0 + 16 * wid + fr) * d.dil; qptr = AttnPtr<ISB>::Q(X, d) + qrow * AttnPtr<ISB>::ldq + 8 * fq; }
        const bool edge = (d.l0 - RAD < 0) || (d.l0 + 128 + RAD > d.L);
        if (!ISB) { qa0 = *(const bf16x8*)qptr; qa1 = *(const bf16x8*)(qptr + 32); }
        const int nx = uu + X.G; bf16x8 qb0 = qa0, qb1 = qa1;
        dn = d; if (nx < nunits) { if (ISB) decode_b(nx, dn); else decode_c(nx, dn); attn_load<RAD, ISB>(X, dn, tid, kr, vr);
            const size_t qrow = (size_t)dn.row_base + (size_t)(dn.l0 + 16 * wid + fr) * dn.dil; const bf16_t* qp = AttnPtr<ISB>::Q(X, dn) + qrow * AttnPtr<ISB>::ldq + 8 * fq;
            if (ISB) { qb0 = *(const bf16x8*)qp; qb1 = *(const bf16x8*)(qp + 32); } }
#pragma unroll 1
        for (int g = 0; g < G; ++g) {
            bf16x8 qn0 = qa0, qn1 = qa1;
            if (g + 1 < G) { qn0 = *(const bf16x8*)(qptr + (g + 1) * 64); qn1 = *(const bf16x8*)(qptr + (g + 1) * 64 + 32); }
            attn_head<RAD, SINK, ISB, TAB>(lds, X, d, g, qa0, qa1, sscale, sinkp, wid, fr, fq, arf, edge);
            qa0 = qn0; qa1 = qn1;
        }
        __syncthreads();
        d = dn; if (ISB) { qa0 = qb0; qa1 = qb1; }
    }
}
__device__ __forceinline__ void phase_merge_b(const Ctx& X) {
    const int nitems = T * 64;
    for (int idx = X.bid * NTHREADS + tid_l(); idx < nitems; idx += X.G * NTHREADS) {
        const int t = idx >> 6, h = (idx >> 3) & 7, dc = idx & 7;
        const float l0 = X_lse[(size_t)t * 8 + h], l1 = X_lse[(size_t)(T + t) * 8 + h], l2 = X_lse[(size_t)(2 * T + t) * 8 + h];
        const float m = fmaxf(l0, fmaxf(l1, l2)); float w0 = __expf(l0 - m), w1 = __expf(l1 - m), w2 = __expf(l2 - m); const float inv = 1.f / (w0 + w1 + w2); w0 *= inv; w1 *= inv; w2 *= inv;
        const size_t off = (size_t)t * 512 + h * 64 + dc * 8;
        const u32x4 a = *(const u32x4*)(X_ob + off), b = *(const u32x4*)(X_ob + (size_t)T * 512 + off), c = *(const u32x4*)(X_ob + (size_t)2 * T * 512 + off);
        u32x4 o;
        o.x = cvt_pk_bf16(w0 * bflo(a.x) + w1 * bflo(b.x) + w2 * bflo(c.x), w0 * bfhi(a.x) + w1 * bfhi(b.x) + w2 * bfhi(c.x));
        o.y = cvt_pk_bf16(w0 * bflo(a.y) + w1 * bflo(b.y) + w2 * bflo(c.y), w0 * bfhi(a.y) + w1 * bfhi(b.y) + w2 * bfhi(c.y));
        o.z = cvt_pk_bf16(w0 * bflo(a.z) + w1 * bflo(b.z) + w2 * bflo(c.z), w0 * bfhi(a.z) + w1 * bfhi(b.z) + w2 * bfhi(c.z));
        o.w = cvt_pk_bf16(w0 * bflo(a.w) + w1 * bflo(b.w) + w2 * bflo(c.w), w0 * bfhi(a.w) + w1 * bfhi(b.w) + w2 * bfhi(c.w));
        *(u32x4*)(X_mix + (size_t)t * 1024 + 512 + h * 64 + dc * 8) = o;
    }
}

__device__ __forceinline__ float logsigmoid_f(float g) { return fminf(g, 0.f) - log1pf(__expf(-fabsf(g))); }
__device__ __forceinline__ void phase_m1(unsigned char* lds, const Ctx& X, int j) {
    bf16_t* kS = (bf16_t*)lds; bf16_t* vS0 = kS + 64 * 144; bf16_t* vS1 = vS0 + 64 * 144; float* wa = (float*)(vS1 + 64 * 144);
    const int tid = tid_l(), lane = tid & 63, wid = tid >> 6, fr = lane & 15, fq = lane >> 4;
    const float* gb = X_ab_gate_b + j * 16;
    for (int uu = X.bid; uu < 1024; uu += X.G) {
        const int tc = uu & 127, h = (uu >> 7) & 3, b = uu >> 9; const int rowbase = b * SEQ + tc * 64; const int st0 = (b * 4 + h) * 2;
        if (wid < 2) {
            const int dd = wid; const int tok = dd ? 63 - lane : lane; const size_t row = (size_t)rowbase + tok;
            const int stream = st0 + dd, c = dd ? 127 - tc : tc;
            const float gi = X_gates[row * 16 + dd * 4 + h] + gb[dd * 4 + h];
            const float gf = X_gates[row * 16 + 8 + dd * 4 + h] + gb[8 + dd * 4 + h];
            const float bcum = incl_sum(logsigmoid_f(gf), lane); const float u = gi - bcum; const float pm = incl_max(u, lane);
            const float pm63 = __shfl(pm, 63), bl = __shfl(bcum, 63);
            wa[dd * 64 + tok] = __expf(u - pm63);
            if (lane == 0) { X_mc[stream * 128 + c] = bl + pm63; X_bc[stream * 128 + c] = bl; }
        }
        u32x4 kv[2], vv[2];
#pragma unroll
        for (int i = 0; i < 2; ++i) { const int p = tid + i * NTHREADS; const int jj = p >> 4, ec = p & 15; const size_t row = (size_t)rowbase + jj;
            kv[i] = *(const u32x4*)(X_kc + row * 512 + h * 128 + ec * 8); vv[i] = *(const u32x4*)(X_big + row * AB_LD + PC_V + h * 128 + ec * 8); }
        __syncthreads();
#pragma unroll
        for (int i = 0; i < 2; ++i) { const int p = tid + i * NTHREADS; const int jj = p >> 4, ec = p & 15;
            *(u32x4*)(kS + jj * 144 + ec * 8) = kv[i];
            const float w0 = wa[jj], w1 = wa[64 + jj]; const u32x4 v = vv[i];
            u32x4 a; a.x = cvt_pk_bf16(bflo(v.x) * w0, bfhi(v.x) * w0); a.y = cvt_pk_bf16(bflo(v.y) * w0, bfhi(v.y) * w0); a.z = cvt_pk_bf16(bflo(v.z) * w0, bfhi(v.z) * w0); a.w = cvt_pk_bf16(bflo(v.w) * w0, bfhi(v.w) * w0);
            u32x4 c; c.x = cvt_pk_bf16(bflo(v.x) * w1, bfhi(v.x) * w1); c.y = cvt_pk_bf16(bflo(v.y) * w1, bfhi(v.y) * w1); c.z = cvt_pk_bf16(bflo(v.z) * w1, bfhi(v.z) * w1); c.w = cvt_pk_bf16(bflo(v.w) * w1, bfhi(v.w) * w1);
            *(u32x4*)(vS0 + jj * 144 + ec * 8) = a; *(u32x4*)(vS1 + jj * 144 + ec * 8) = c; }
        __syncthreads();
        {
            const int trrow = 4 * fq + (fr >> 2), trcol = 4 * (fr & 3);
            bf16x8 bf0[2], bf1[2];
#pragma unroll
            for (int ks = 0; ks < 2; ++ks) {
                const bf16_t* vp = vS0 + (32 * ks + trrow) * 144 + 16 * wid + trcol; const u32x2 lo = tr_read(vp), hi = tr_read(vp + 16 * 144); bf0[ks] = __builtin_bit_cast(bf16x8, ((u32x4){lo.x, lo.y, hi.x, hi.y}));
                const bf16_t* vq = vS1 + (32 * ks + trrow) * 144 + 16 * wid + trcol; const u32x2 lo1 = tr_read(vq), hi1 = tr_read(vq + 16 * 144); bf1[ks] = __builtin_bit_cast(bf16x8, ((u32x4){lo1.x, lo1.y, hi1.x, hi1.y})); }
            bf16_t* cd0 = X_cst + (size_t)(st0 * 128 + tc) * 16384 + (size_t)(16 * wid + fr) * 128 + 4 * fq;
            bf16_t* cd1 = X_cst + (size_t)((st0 + 1) * 128 + (127 - tc)) * 16384 + (size_t)(16 * wid + fr) * 128 + 4 * fq;
#pragma unroll
            for (int eb = 0; eb < 8; ++eb) {
                f32x4 a0 = (f32x4){0.f, 0.f, 0.f, 0.f}, a1 = (f32x4){0.f, 0.f, 0.f, 0.f};
#pragma unroll
                for (int ks = 0; ks < 2; ++ks) { const bf16_t* kp = kS + (32 * ks + trrow) * 144 + 16 * eb + trcol; const u32x2 lo = tr_read(kp), hi = tr_read(kp + 16 * 144);
                    const bf16x8 kf = __builtin_bit_cast(bf16x8, ((u32x4){lo.x, lo.y, hi.x, hi.y}));
                    a0 = mma16(kf, bf0[ks], a0); a1 = mma16(kf, bf1[ks], a1); }
                u32x2 w; w.x = cvt_pk_bf16(a0[0], a0[1]); w.y = cvt_pk_bf16(a0[2], a0[3]); *(u32x2*)(cd0 + 16 * eb) = w;
                u32x2 y; y.x = cvt_pk_bf16(a1[0], a1[1]); y.y = cvt_pk_bf16(a1[2], a1[3]); *(u32x2*)(cd1 + 16 * eb) = y;
            }
            const int e = tid >> 2, dd = (tid >> 1) & 1, hf = tid & 1; float sm = 0.f;
#pragma unroll
            for (int i = 0; i < 32; ++i) sm += bf2f(kS[(32 * hf + i) * 144 + e]) * wa[dd * 64 + 32 * hf + i];
            sm += __shfl_xor(sm, 1);
            if (hf == 0) X_nst[(size_t)((st0 + dd) * 128 + (dd ? 127 - tc : tc)) * 128 + e] = sm;
        }
        __syncthreads();
    }
}
template <bool DRY>
__device__ __forceinline__ void phase_m2(unsigned char* lds, const Ctx& X) {
    float* mcL = (float*)lds; float* bcL = mcL + 128; float* soL = bcL + 128; float* snL = soL + 128; float* mpL = snL + 128;
    const int tid = tid_l();
    for (int wi = X.bid; wi < 256; wi += X.G) {
        const int stream = wi >> 4, sl = wi & 15;
        if (tid < 128) { mcL[tid] = X_mc[stream * 128 + tid]; bcL[tid] = X_bc[stream * 128 + tid]; }
        __syncthreads();
        if (tid == 0) {
            float m = 0.f;
#pragma unroll 4
            for (int c = 0; c < 128; ++c) { const float mcv = mcL[c], bcv = bcL[c]; mpL[c] = m; const float mn = fmaxf(bcv + m, mcv); soL[c] = __expf(bcv + m - mn); snL[c] = __expf(mcv - mn); m = mn; }
        }
        __syncthreads();
        if (!DRY && sl == 0 && tid < 128) X_mprev[stream * 128 + tid] = mpL[tid];
        {
            unsigned* p = (unsigned*)(X_cst + (size_t)stream * 128 * 16384) + sl * 512 + tid;
            float c0 = 0.f, c1 = 0.f;
#pragma unroll 1
            for (int cb = 0; cb < 128; cb += 16) {
                unsigned v[16];
#pragma unroll
                for (int i = 0; i < 16; ++i) v[i] = p[(size_t)(cb + i) * 8192];
#pragma unroll
                for (int i = 0; i < 16; ++i) {
                    if (!DRY || c0 == 12345.678f) p[(size_t)(cb + i) * 8192] = cvt_pk_bf16(c0, c1);
                    const float so = soL[cb + i], sn = snL[cb + i];
                    c0 = so * c0 + sn * bflo(v[i]); c1 = so * c1 + sn * bfhi(v[i]);
                }
            }
        }
        if (sl == 0 && tid < 128) {
            float* p = X_nst + (size_t)stream * 128 * 128 + tid; float n0 = 0.f;
#pragma unroll 1
            for (int cb = 0; cb < 128; cb += 16) {
                float v[16];
#pragma unroll
                for (int i = 0; i < 16; ++i) v[i] = p[(cb + i) * 128];
#pragma unroll
                for (int i = 0; i < 16; ++i) { if (!DRY || n0 == 12345.678f) p[(cb + i) * 128] = n0; n0 = soL[cb + i] * n0 + snL[cb + i] * v[i]; }
            }
        }
        __syncthreads();
    }
}
__device__ __forceinline__ void phase_m3(unsigned char* lds, const Ctx& X, int j) {
    bf16_t* qL = (bf16_t*)lds;
    bf16_t* kL = qL + 64 * 136;
    bf16_t* vS = kL + 64 * 136;
    float* hbuf = (float*)(vS + 64 * 144);
    float* gt = hbuf + 64 * 132;
    float* nP = gt + 512;
    const int tid = tid_l(), lane = tid & 63, wid = tid >> 6, fr = lane & 15, fq = lane >> 4;
    const float* gb = X_ab_gate_b + j * 16; const float* hg = X_ab_hnorm_g + j * 512;
    for (int uu = X.bid; uu < 1024; uu += X.G) {
        int uv = uu; asm volatile("" : "+v"(uv));
        const int tc = uv & 127, h = (uv >> 7) & 3, b = uv >> 9; const int rowbase = b * SEQ + tc * 64;
        const int st0 = (b * 4 + h) * 2;
        bf16x8 cf[4][4];
        { const bf16_t* cbase = X_cst + (size_t)(st0 * 128 + tc) * 16384 + (size_t)(64 * (wid & 1) + fr) * 128 + 8 * fq;
#pragma unroll
          for (int dbi = 0; dbi < 4; ++dbi)
#pragma unroll
              for (int ks = 0; ks < 4; ++ks) cf[dbi][ks] = *(const bf16x8*)(cbase + (size_t)dbi * 16 * 128 + 32 * ks); }
        if (wid < 2) {
            const int dd = wid; const int tok = dd ? 63 - lane : lane; const size_t row = (size_t)rowbase + tok;
            const int stream = st0 + dd, c = dd ? 127 - tc : tc;
            const float gi = X_gates[row * 16 + dd * 4 + h] + gb[dd * 4 + h];
            const float gf = X_gates[row * 16 + 8 + dd * 4 + h] + gb[8 + dd * 4 + h];
            const float bcum = incl_sum(logsigmoid_f(gf), lane); const float u = gi - bcum; const float pm = incl_max(u, lane);
            const float mp = X_mprev[stream * 128 + c]; const float M = fmaxf(mp, pm);
            float* g4 = gt + 256 * dd;
            g4[tok] = u; g4[64 + tok] = M; g4[128 + tok] = __expf(mp - M); g4[192 + tok] = __expf(-(bcum + M));
        } else if (wid < 4) {
            const int dd = wid - 2; const int stream = st0 + dd, c = dd ? 127 - tc : tc;
            nP[dd * 128 + lane] = X_nst[(size_t)(stream * 128 + c) * 128 + lane]; nP[dd * 128 + lane + 64] = X_nst[(size_t)(stream * 128 + c) * 128 + lane + 64];
        }
        for (int p = tid; p < 1024; p += NTHREADS) {
            const int jj = p >> 4, ec = p & 15; const size_t row = (size_t)rowbase + jj;
            *(u32x4*)(qL + jj * 136 + ec * 8) = *(const u32x4*)(X_qc + row * 512 + h * 128 + ec * 8);
            *(u32x4*)(kL + jj * 136 + ec * 8) = *(const u32x4*)(X_kc + row * 512 + h * 128 + ec * 8);
            *(u32x4*)(vS + jj * 144 + ec * 8) = *(const u32x4*)(X_big + row * AB_LD + PC_V + h * 128 + ec * 8);
        }
        const int ntok = tid >> 3, npart = tid & 7; const size_t nrow = (size_t)rowbase + ntok; const int ncol = h * 128 + npart * 16;
        const u32x4 o0 = *(const u32x4*)(X_big + nrow * AB_LD + PC_O + ncol), o1 = *(const u32x4*)(X_big + nrow * AB_LD + PC_O + ncol + 8);
        __syncthreads();
        {
            const int tb = wid >> 1, dh = wid & 1; const int t = 16 * tb + fr;
            bf16x8 qf[4];
#pragma unroll
            for (int ks = 0; ks < 4; ++ks) qf[ks] = *(const bf16x8*)(qL + t * 136 + 32 * ks + 8 * fq);
            const float M0 = gt[64 + t], si0 = gt[128 + t], em0 = gt[192 + t], M1 = gt[256 + 64 + t], si1 = gt[256 + 128 + t], em1 = gt[256 + 192 + t];
            float qn0 = 0.f, qn1 = 0.f;
#pragma unroll
            for (int ks = 0; ks < 4; ++ks)
#pragma unroll
                for (int i = 0; i < 8; ++i) { const float qv = bf2f((unsigned short)qf[ks][i]); qn0 += qv * nP[32 * ks + 8 * fq + i]; qn1 += qv * nP[128 + 32 * ks + 8 * fq + i]; }
            qn0 += __shfl_xor(qn0, 16); qn0 += __shfl_xor(qn0, 32); qn1 += __shfl_xor(qn1, 16); qn1 += __shfl_xor(qn1, 32);
            f32x4 sw0[4], sw1[4]; float ds0 = 0.f, ds1 = 0.f;
#pragma unroll
            for (int sb = 0; sb < 4; ++sb) {
                f32x4 a = (f32x4){0.f, 0.f, 0.f, 0.f};
                const bf16_t* kr = kL + (16 * sb + fr) * 136 + 8 * fq;
#pragma unroll
                for (int ks = 0; ks < 4; ++ks) a = mma16(*(const bf16x8*)(kr + 32 * ks), qf[ks], a);
#pragma unroll
                for (int r = 0; r < 4; ++r) { const int s = 16 * sb + 4 * fq + r;
                    const float w0 = (s <= t) ? __expf(gt[s] - M0) * a[r] : 0.f, w1 = (s >= t) ? __expf(gt[256 + s] - M1) * a[r] : 0.f;
                    sw0[sb][r] = w0; sw1[sb][r] = w1; ds0 += w0; ds1 += w1; }
            }
            ds0 += __shfl_xor(ds0, 16); ds0 += __shfl_xor(ds0, 32); ds1 += __shfl_xor(ds1, 16); ds1 += __shfl_xor(ds1, 32);
            const float inv0 = 1.f / fmaxf(fabsf(ds0 + si0 * qn0), em0), inv1 = 1.f / fmaxf(fabsf(ds1 + si1 * qn1), em1);
            bf16x8 wf0[2], wf1[2];
#pragma unroll
            for (int ss2 = 0; ss2 < 2; ++ss2) {
                u32x4 pw; pw.x = cvt_pk_bf16(sw0[2 * ss2][0], sw0[2 * ss2][1]); pw.y = cvt_pk_bf16(sw0[2 * ss2][2], sw0[2 * ss2][3]); pw.z = cvt_pk_bf16(sw0[2 * ss2 + 1][0], sw0[2 * ss2 + 1][1]); pw.w = cvt_pk_bf16(sw0[2 * ss2 + 1][2], sw0[2 * ss2 + 1][3]); wf0[ss2] = __builtin_bit_cast(bf16x8, pw);
                u32x4 pv; pv.x = cvt_pk_bf16(sw1[2 * ss2][0], sw1[2 * ss2][1]); pv.y = cvt_pk_bf16(sw1[2 * ss2][2], sw1[2 * ss2][3]); pv.z = cvt_pk_bf16(sw1[2 * ss2 + 1][0], sw1[2 * ss2 + 1][1]); pv.w = cvt_pk_bf16(sw1[2 * ss2 + 1][2], sw1[2 * ss2 + 1][3]); wf1[ss2] = __builtin_bit_cast(bf16x8, pv);
            }
            f32x4 h0[4], b1[4];
#pragma unroll
            for (int dbi = 0; dbi < 4; ++dbi) {
                const int db = 4 * dh + dbi;
                f32x4 a10 = (f32x4){0.f, 0.f, 0.f, 0.f}, a11 = (f32x4){0.f, 0.f, 0.f, 0.f}, a2 = (f32x4){0.f, 0.f, 0.f, 0.f};
#pragma unroll
                for (int ss2 = 0; ss2 < 2; ++ss2) {
                    const bf16_t* vr = vS + (32 * ss2 + 4 * fq + (fr >> 2)) * 144 + 16 * db + 4 * (fr & 3);
                    const u32x2 lo = tr_read(vr), hi = tr_read(vr + 16 * 144);
                    const bf16x8 vf = __builtin_bit_cast(bf16x8, ((u32x4){lo.x, lo.y, hi.x, hi.y}));
                    a10 = mma16(vf, wf0[ss2], a10); a11 = mma16(vf, wf1[ss2], a11);
                }
#pragma unroll
                for (int ks = 0; ks < 4; ++ks) a2 = mma16(cf[dbi][ks], qf[ks], a2);
                h0[dbi] = (a10 + a2 * si0) * inv0; b1[dbi] = a11;
            }
            { const bf16_t* cbase = X_cst + (size_t)((st0 + 1) * 128 + (127 - tc)) * 16384 + (size_t)(64 * dh + fr) * 128 + 8 * fq;
#pragma unroll
              for (int dbi = 0; dbi < 4; ++dbi)
#pragma unroll
                  for (int ks = 0; ks < 4; ++ks) cf[dbi][ks] = *(const bf16x8*)(cbase + (size_t)dbi * 16 * 128 + 32 * ks); }
#pragma unroll
            for (int dbi = 0; dbi < 4; ++dbi) {
                const int db = 4 * dh + dbi;
                f32x4 a2 = (f32x4){0.f, 0.f, 0.f, 0.f};
#pragma unroll
                for (int ks = 0; ks < 4; ++ks) a2 = mma16(cf[dbi][ks], qf[ks], a2);
                const f32x4 hv = h0[dbi] + (b1[dbi] + a2 * si1) * inv1;
                *(f32x4*)(hbuf + t * 132 + 16 * db + 4 * fq) = hv;
            }
        }
        __syncthreads();
        {
            const float* hp = hbuf + ntok * 132 + npart * 16; float v[16]; float sq = 0.f;
#pragma unroll
            for (int i = 0; i < 16; ++i) { v[i] = hp[i]; sq += v[i] * v[i]; }
            sq += __shfl_xor(sq, 1); sq += __shfl_xor(sq, 2); sq += __shfl_xor(sq, 4);
            const float r = rsqrtf(sq * (1.f / 128.f) + EPS);
            const unsigned ow[8] = {o0.x, o0.y, o0.z, o0.w, o1.x, o1.y, o1.z, o1.w};
            unsigned res[8];
#pragma unroll
            for (int i = 0; i < 8; ++i) {
                const float y0 = v[2 * i] * r * hg[ncol + 2 * i] * sigmoid_f(bflo(ow[i])), y1 = v[2 * i + 1] * r * hg[ncol + 2 * i + 1] * sigmoid_f(bfhi(ow[i]));
                res[i] = cvt_pk_bf16(y0, y1);
            }
            *(u32x4*)(X_mix + nrow * 1024 + ncol) = (u32x4){res[0], res[1], res[2], res[3]};
            *(u32x4*)(X_mix + nrow * 1024 + ncol + 8) = (u32x4){res[4], res[5], res[6], res[7]};
        }
        __syncthreads();
    }
}


#define XB_TMO      128
#define XB_XCNT(j)  (256  + 64 * (j))
#define XB_XSUB(j)  (1280 + 64 * (j))
#define XB_XGEN(j)  (2304 + 64 * (j))
#define XB_TOP      3328
#define XB_TOPGEN   3392
#define XCD_BAR_WORDS 3456
#define XB_SPIN_CAP (1u << 18)
__device__ __forceinline__ unsigned xb_ld(unsigned* p)              { return __hip_atomic_load(p, __ATOMIC_RELAXED, __HIP_MEMORY_SCOPE_AGENT); }
__device__ __forceinline__ unsigned xb_add(unsigned* p, unsigned v) { return __hip_atomic_fetch_add(p, v, __ATOMIC_RELAXED, __HIP_MEMORY_SCOPE_AGENT); }
__device__ __forceinline__ unsigned xb_xcc_id() { return (unsigned)__builtin_amdgcn_s_getreg((3 << 11) | 20) & 0xFu; }
#define XB_SPIN(cond, bar) do { unsigned _sp = 0; while (cond) { __builtin_amdgcn_s_sleep(1); \
    if ((++_sp & 255u) == 0u) { if (xb_ld(&(bar)[XB_TMO])) break; if (_sp > XB_SPIN_CAP) { atomicAdd(&(bar)[XB_TMO], 1u); break; } } } } while (0)
struct XcdBarrier { unsigned* bar; unsigned x; volatile LAS unsigned* st; };
__device__ __forceinline__ XcdBarrier xcd_barrier_post(unsigned* bar, volatile LAS unsigned* st) {
    XcdBarrier b; b.bar = bar; b.x = xb_xcc_id(); b.st = st;
    if (threadIdx.x == 0) (void)xb_add(&bar[XB_XCNT(b.x)], 1u);
    return b;
}
__device__ __forceinline__ void xcd_barrier_complete(unsigned* bar, unsigned x, unsigned& nloc, unsigned& nx) {
    const unsigned G = gridDim.x * gridDim.y * gridDim.z;
    unsigned sum, cnt, mine, sp = 0u;
    for (;;) {
        sum = 0u; cnt = 0u; mine = 0u;
#pragma unroll
        for (unsigned j = 0; j < 16; ++j) { const unsigned c = xb_ld(&bar[XB_XCNT(j)]); sum += c; cnt += (c > 0u) ? 1u : 0u; mine = (j == x) ? c : mine; }
        if (sum == G) break;
        __builtin_amdgcn_s_sleep(1);
        if ((++sp & 255u) == 0u) { if (xb_ld(&bar[XB_TMO])) break; if (sp > XB_SPIN_CAP) { atomicAdd(&bar[XB_TMO], 1u); break; } }
    }
    nloc = mine > 0u ? mine : 1u; nx = cnt > 0u ? cnt : 1u;
}
__device__ __forceinline__ void xcd_barrier(const XcdBarrier& b) {
    asm volatile("s_waitcnt vmcnt(0)" ::: "memory");
    __syncthreads();
    if (threadIdx.x == 0) {
        unsigned* bar = b.bar;
        __builtin_amdgcn_s_waitcnt(0);
        unsigned nloc = b.st[0], nx = b.st[1];
        if (nloc == 0u) { xcd_barrier_complete(bar, b.x, nloc, nx); b.st[0] = nloc; b.st[1] = nx; }
        const unsigned old = xb_add(&bar[XB_XSUB(b.x)], 1u);
        const unsigned gen = old / nloc;
        if (old + 1u == (gen + 1u) * nloc) {
            __builtin_amdgcn_fence(__ATOMIC_RELEASE, "agent");
            asm volatile("s_waitcnt vmcnt(0)" ::: "memory");
            const unsigned og = xb_add(&bar[XB_TOP], 1u);
            const unsigned tg = og / nx;
            if (og + 1u == (tg + 1u) * nx) xb_add(&bar[XB_TOPGEN], 1u);
            else XB_SPIN(xb_ld(&bar[XB_TOPGEN]) == tg, bar);
            __builtin_amdgcn_fence(__ATOMIC_ACQUIRE, "agent");
            xb_add(&bar[XB_XGEN(b.x)], 1u);
            asm volatile("s_waitcnt vmcnt(0)" ::: "memory");
        } else {
            XB_SPIN(xb_ld(&bar[XB_XGEN(b.x)]) == gen, bar);
            __builtin_amdgcn_fence(__ATOMIC_ACQUIRE, "agent");
            asm volatile("s_waitcnt vmcnt(0)" ::: "memory");
        }
    }
    __syncthreads();
}
constexpr size_t WS_BAR = WS_END + 4096;
constexpr int LDS_MISC = LDS_BYTES - 64;
#ifdef DEBUG_CHK
constexpr size_t WS_CODE = WS_END + 256;
__global__ void chk_kernel(const void* p, size_t n16, int is_bf16, unsigned* code, unsigned val, float lim) {
    const u32x4* v = (const u32x4*)p; bool bad = false;
    for (size_t i = (size_t)blockIdx.x * blockDim.x + threadIdx.x; i < n16; i += (size_t)gridDim.x * blockDim.x) {
        const u32x4 w = v[i]; const unsigned a[4] = {w.x, w.y, w.z, w.w};
#pragma unroll
        for (int q = 0; q < 4; ++q) {
            if (is_bf16) { const float lo = bflo(a[q]), hi = bfhi(a[q]); if (!(fabsf(lo) < lim) || !(fabsf(hi) < lim)) bad = true; }
            else { const float f = __builtin_bit_cast(float, a[q]); if (!(fabsf(f) < lim)) bad = true; }
        }
    }
    if (bad) atomicMin(code, val);
}
#endif
constexpr int PH_PER_LAYER = 11, PH_FINAL = 1 + 4 * PH_PER_LAYER, N_PHASES = PH_FINAL + 1;
__host__ __device__ inline bool phase_is_noop(int p) { if (p < 1 || p >= PH_FINAL) return false; const int q = p - 1, l = q / PH_PER_LAYER, k = q % PH_PER_LAYER; return ((l & 1) && (k >= 5 && k <= 7)) || (k == 0 && l > 0); }

__global__ void __launch_bounds__(NTHREADS, 2) fwd_kernel(Args args) {
    extern __shared__ __attribute__((aligned(16))) unsigned char lds[];
    volatile LAS unsigned* xst = (volatile LAS unsigned*)((LAS unsigned char*)lds + LDS_MISC);
    if (threadIdx.x < 2) xst[threadIdx.x] = 0u;
    __syncthreads();
    XcdBarrier xbar; xbar.bar = (unsigned*)(args.ws + WS_BAR); xbar.x = 0; xbar.st = xst;
    if (!MK_PER_PHASE) xbar = xcd_barrier_post((unsigned*)(args.ws + WS_BAR), xst);
    if (args.ph_lo == 0) {
        if (blockIdx.x == 0 && threadIdx.x < 16) {
            const float** tab = (const float**)(args.ws + WS_TAB);
            const int i = threadIdx.x;
            const float* v = args.out;
#pragma unroll
            for (int k = 0; k < 15; ++k) if (i == k) v = args.in[k];
            tab[i] = v;
        }
        if (args.ph_hi < 0) cg::this_grid().sync();
        if (args.ph_hi > 1) xcd_barrier(xbar);
    }
    const int p_lo = args.ph_lo < 1 ? 1 : args.ph_lo, p_hi = args.ph_hi;
    unsigned char* ws0 = args.ws;
    const int G0 = gridDim.x, bid0 = blockIdx.x;
    for (int pp = 2 * p_lo; pp < 2 * p_hi; ++pp) {
        const int p = pp >> 1;
        if (phase_is_noop(p)) continue;
        const bool dupable = DUPMASK != 0 && p != PH_FINAL && ((DUPMASK >> ((p - 1) % PH_PER_LAYER)) & 1);
        if ((pp & 1) && !dupable) continue;
        Ctx X; X.G = G0; X.bid = bid0;
        { size_t z = 0; asm volatile("" : "+s"(z)); X.ws = ws0 + z; }
        LAS unsigned char* ldsl = (LAS unsigned char*)lds;
        if (p == PH_FINAL) {
#ifdef DEBUG_CHK
            const unsigned code = *(const unsigned*)(X.ws + WS_CODE);
            if (code < 1000u) {
                const float a = sqrtf(0.2f * (float)code);
                for (size_t i = (size_t)X.bid * NTHREADS + threadIdx.x; i < (size_t)T * D; i += (size_t)X.G * NTHREADS) X_out[i] = (i & 1) ? a : -a;
            } else
#endif
            if (PHON(11)) phase_final(X); }
        else {
            const int q = p - 1, l = q / PH_PER_LAYER, k = q - l * PH_PER_LAYER, j = l >> 1; const bool even = (l & 1) == 0;
            if (k == 0) { if (PHON(0)) { phase_convert(lds, X, 0, 3, X.bid, X.G); phase_init(X); } }
            else if (PHON(1) && (k == 1 || k == 9)) {
                pg8::Gemm g{X_xb, k == 1 ? X_Wup1 : X_Wup2, T, NUP, D}; pg8::StaticOrder S; S.init(T, NUP, X.G, X.bid);
                pg8::fill_rstd(ldsl, X_ss, S);
                pg8::EpiUp E{X_big, (LAS const float*)(ldsl + pg8::LDS_RTAB)};
                for (int r = 0; r < GEMM_REPS; ++r) { pg8::gemm_phase<pg8::EpiUp, pg8::StaticOrder, true, true>(ldsl, g, S, E); if (r + 1 < GEMM_REPS) __syncthreads(); }
                if ((k == 9 && l < 3) || (k == 1 && l > 0)) convert_in_tail(lds, X, k == 9 ? l + 1 : l, k == 9 ? 1 : 2, (T / 256) * (NUP / 256));
            } else if (PHON(2) && (k == 2 || k == 10)) {
                pg8::Gemm g{X_big, k == 2 ? X_Wdn1 : X_Wdn2, T, D, FF}; pg8::StaticOrder S; S.init(T, D, X.G, X.bid);
                GAS float* outp = (GAS float*)X_out;
                for (int r = 0; r < GEMM_REPS; ++r) { pg8::EpiRes E{(l == 0 && k == 2) ? (GAS const float*)X_x : (GAS const float*)outp, outp, X_xb, X_ss, (r + 1 < GEMM_REPS) ? 0.f : 0.5f};
                pg8::gemm_phase<pg8::EpiRes, pg8::StaticOrder, false, true>(ldsl, g, S, E); if (r + 1 < GEMM_REPS) __syncthreads(); }
            } else if (PHON(3) && k == 3) {
                const int N = even ? AB_N : C_N;
                pg8::Gemm g{X_xb, X_Win, T, N, D}; pg8::StaticOrder S; S.init(T, N, X.G, X.bid);
                pg8::fill_rstd(ldsl, X_ss, S);
                pg8::EpiProj E{X_big, even ? AB_LD : C_N, (LAS const float*)(ldsl + pg8::LDS_RTAB), X_gates, even ? 14 : -1};
                for (int r = 0; r < GEMM_REPS; ++r) { pg8::gemm_phase<pg8::EpiProj, pg8::StaticOrder, true, true>(ldsl, g, S, E); if (r + 1 < GEMM_REPS) __syncthreads(); }
            } else if (k == 4) {
                { if (even) { if (PHON(4)) { phase_attn<64, 1, false, true>(lds, X, 3072, 1.0f, nullptr); phase_conv(X, j); } } else { if (PHON(12)) phase_attn<128, 4, true, false>(lds, X, 512, 0.5f, X_c_sink + j * 16); } }
            } else if (PHON(5) && k == 5) { phase_m1(lds, X, j); }
            else if (PHON(6) && k == 6) { if (pp & 1) phase_m2<true>(lds, X); else phase_m2<false>(lds, X); }
            else if (PHON(7) && k == 7) { { phase_m3(lds, X, j); phase_merge_b(X); } }
            else if (PHON(8) && k == 8) {
                pg8::Gemm g{X_mix, X_Wout, T, D, D}; pg8::StaticOrder S; S.init(T, D, X.G, X.bid);
                GAS float* outp = (GAS float*)X_out;
                for (int r = 0; r < GEMM_REPS; ++r) { pg8::EpiRes E{(GAS const float*)outp, outp, X_xb, X_ss, (r + 1 < GEMM_REPS) ? 0.f : 1.0f};
                pg8::gemm_phase<pg8::EpiRes, pg8::StaticOrder, false, true>(ldsl, g, S, E); if (r + 1 < GEMM_REPS) __syncthreads(); }
            }
        }
        if (p + 1 < p_hi || (!(pp & 1) && dupable)) { for (int r = 0; r < SYNC_REPS; ++r) xcd_barrier(xbar); }
    }
}

extern "C" void kernel_launch(void* const* d_in, const int* in_sizes, int n_in, void* d_out, int out_size, void* d_ws, size_t ws_size, hipStream_t stream) {
    static int grid = 0;
    if (grid == 0) {
        int dev = 0, cus = 0, per_cu = 0;
        hipGetDevice(&dev);
        hipDeviceGetAttribute(&cus, hipDeviceAttributeMultiprocessorCount, dev);
        hipFuncSetAttribute((const void*)fwd_kernel, hipFuncAttributeMaxDynamicSharedMemorySize, LDS_BYTES);
        hipOccupancyMaxActiveBlocksPerMultiprocessor(&per_cu, (const void*)fwd_kernel, NTHREADS, LDS_BYTES);
        if (per_cu < 1) per_cu = 1;
        if (per_cu > 1) per_cu = 1;
        grid = cus * per_cu;
        if (ws_size < WS_END) fprintf(stderr, "kernel_launch: workspace too small (%zu < %zu)\n", ws_size, (size_t)WS_END);
        (void)hipGetLastError();
    }
    if (ws_size < WS_END + 32768) return;
    Args a{};
    for (int i = 0; i < 15; ++i) a.in[i] = (const float*)d_in[i];
    a.out = (float*)d_out; a.ws = (unsigned char*)d_ws;
#if MK_PER_PHASE
#ifdef DEBUG_CHK
    int seq = 0; hipMemsetAsync((unsigned char*)d_ws + WS_END + 256, 0x7F, 4, stream);
#endif
    for (int p = 0; p < N_PHASES; ++p) {
        if (phase_is_noop(p)) continue;
        a.ph_lo = p; a.ph_hi = p + 1;
        hipLaunchKernelGGL(fwd_kernel, dim3(grid), dim3(NTHREADS), LDS_BYTES, stream, a);
#ifdef DEBUG_CHK
        if (p >= 1 && p < PH_FINAL) {
            ++seq; const int q = p - 1, l = q / PH_PER_LAYER, k = q % PH_PER_LAYER; const bool even = (l & 1) == 0;
            unsigned char* w = (unsigned char*)d_ws; unsigned* code = (unsigned*)(w + WS_CODE);
#define CHK(ptr, bytes, isb) hipLaunchKernelGGL(chk_kernel, dim3(1024), dim3(256), 0, stream, (const void*)(ptr), (size_t)(bytes) / 16, isb, code, (unsigned)seq, lim)
            float lim = 300.f;
            if (k == 0) { CHK(w, 43 * MiB, 1); if (l == 0) { CHK(w + WS_XB, (size_t)T * D * 2, 1); lim = 1e5f; CHK(w + WS_SS, (size_t)T * 64, 0); } }
            else if (k == 1 || k == 9) { CHK(w + WS_BIG, (size_t)T * FF * 2, 1); }
            else if (k == 2 || k == 10 || k == 8) { CHK(d_out, (size_t)T * D * 4, 0); CHK(w + WS_XB, (size_t)T * D * 2, 1); lim = 1e5f; CHK(w + WS_SS, (size_t)T * 64, 0); }
            else if (k == 3) { CHK(w + WS_BIG, (size_t)T * (even ? AB_LD : C_N) * 2, 1); if (even) CHK(w + WS_GATES, (size_t)T * 64, 0); }
            else if (k == 4) { if (even) { CHK(w + WS_OB, (size_t)3 * T * 512 * 2, 1); CHK(w + WS_LSE, (size_t)3 * T * 32, 0); CHK(w + WS_XB, (size_t)T * D * 2, 1); } else CHK(w + WS_MIX, (size_t)T * D * 2, 1); }
            else if (k == 5) { lim = 3e3f; CHK(w + WS_CST, 64 * MiB, 1); CHK(w + WS_NST, 1 * MiB, 0); CHK(w + WS_MSC, 16384, 0); }
            else if (k == 6) { lim = 3e3f; CHK(w + WS_CST, 64 * MiB, 1); CHK(w + WS_NST, 1 * MiB, 0); CHK(w + WS_MSC, 24576, 0); }
            else if (k == 7) { CHK(w + WS_MIX, (size_t)T * D * 2, 1); }
        }
#endif
    }
#else
    a.ph_lo = 0; a.ph_hi = N_PHASES;
    hipMemsetAsync((unsigned char*)d_ws + WS_BAR, 0, 16384, stream);
    void* kargs[] = {&a};
    hipError_t e = hipLaunchCooperativeKernel((const void*)fwd_kernel, dim3(grid), dim3(NTHREADS), kargs, LDS_BYTES, stream);
    if (e != hipSuccess) fprintf(stderr, "cooperative launch failed: %s (grid %d)\n", hipGetErrorString(e), grid);
#endif
}
```
